# Optimizing an MI355X kernel written in HIP

```python
import math
import jax
import jax.numpy as jnp
from jax import lax
import numpy as np

D_MODEL = 4096
BATCH = 1
SEQ = 8192
DEPTH = 4

GRID_W = 64
CTX_LEN = 256
N_MIXERS = 4
ADA_RANK = D_MODEL // 4
D_FF = ((8 * D_MODEL + 3 * 256 - 1) // (3 * 256)) * 256
RMS_EPS = 1e-6
NEG_INF = -1e30
HEAD_DIM = 128
ROPE_BASE = 10000.0
POOL_WINDOWS = (2, 4, 8, 16)
POOL_GROUP = D_MODEL // len(POOL_WINDOWS)
S5_GROUP = 16
S5_GROUPS = D_MODEL // S5_GROUP
S5_STATE = 64
S5_CHUNK = 128
SWA_HEADS = D_MODEL // HEAD_DIM
SWA_KV_HEADS = SWA_HEADS // 4
SWA_WINDOW = 128
SWA_BLOCK = 128
NA_HEADS = D_MODEL // HEAD_DIM
NA_WIN_ROWS = 8
NA_WIN_COLS = 16

kernel_name = 'hybrid_interleaved_diffusion_block'


def _rmsnorm(x, gain):
    xf = x.astype(jnp.float32)
    xf = xf * lax.rsqrt(jnp.mean(xf * xf, axis=-1, keepdims=True) + RMS_EPS)
    return (xf * gain.astype(jnp.float32)).astype(x.dtype)


def _adaln(cvec, w_down, w_up, b):
    m = (jax.nn.silu(cvec) @ w_down) @ w_up + b
    return m.reshape(m.shape[:-1] + (6, cvec.shape[-1]))


def _modulate(u, shift, scale):
    return u * (1 + scale) + shift


def _swiglu(u, w_gate_up, w_down):
    a, g = jnp.split(u @ w_gate_up, 2, axis=-1)
    return (jax.nn.silu(a) * g) @ w_down


def _axial_rope(x, rows, cols):
    hd = x.shape[-1]
    half = hd // 2
    quarter = half // 2
    inv = jnp.power(ROPE_BASE, -jnp.arange(quarter, dtype=jnp.float32) / quarter)
    xf = x.astype(jnp.float32)

    def rot(xs, pos):
        ang = pos.astype(jnp.float32)[:, None] * inv
        cos = jnp.cos(ang)[None, :, None, :]
        sin = jnp.sin(ang)[None, :, None, :]
        x1, x2 = xs[..., :quarter], xs[..., quarter:]
        return jnp.concatenate([x1 * cos - x2 * sin, x2 * cos + x1 * sin], axis=-1)

    return jnp.concatenate([rot(xf[..., :half], rows), rot(xf[..., half:], cols)], axis=-1).astype(x.dtype)


def _pool_mixer(u, pool_w, pool_scale):
    bsz, length, width = u.shape
    uf = u.astype(jnp.float32)
    cs = jnp.concatenate([jnp.zeros((bsz, 1, width), jnp.float32), jnp.cumsum(uf, axis=1)], axis=1)
    t = jnp.arange(length)
    groups = []
    for gi, w in enumerate(POOL_WINDOWS):
        lo = jnp.clip(t - w // 2, 0, length)
        hi = jnp.clip(t + w // 2, 0, length)
        sl = slice(gi * POOL_GROUP, (gi + 1) * POOL_GROUP)
        csg = cs[:, :, sl]
        mean = (csg[:, hi] - csg[:, lo]) / (hi - lo).astype(jnp.float32)[None, :, None]
        groups.append(mean - uf[:, :, sl])
    p = jnp.stack(groups, axis=2)
    y = jnp.einsum('blgc,gcd->blgd', p, pool_w.astype(jnp.float32)).reshape(bsz, length, width)
    return (y * pool_scale.astype(jnp.float32)).astype(u.dtype)


def _complex_affine_combine(e1, e2):
    a1r, a1i, b1r, b1i = e1
    a2r, a2i, b2r, b2i = e2
    return (a2r * a1r - a2i * a1i, a2r * a1i + a2i * a1r,
            a2r * b1r - a2i * b1i + b2r, a2r * b1i + a2i * b1r + b2i)


def _s5_scan(u, lam_re, lam_im, log_step, b_re, b_im, c_re, c_im, h_re, h_im):
    bsz, length = u.shape[:2]
    dt = jnp.exp(log_step)[:, None]
    z_re, z_im = lam_re * dt, lam_im * dt
    mag = jnp.exp(z_re)
    a_re, a_im = mag * jnp.cos(z_im), mag * jnp.sin(z_im)
    den = lam_re * lam_re + lam_im * lam_im
    k_re = ((a_re - 1.0) * lam_re + a_im * lam_im) / den
    k_im = (a_im * lam_re - (a_re - 1.0) * lam_im) / den
    bb_re = k_re[..., None] * b_re - k_im[..., None] * b_im
    bb_im = k_re[..., None] * b_im + k_im[..., None] * b_re
    chunk = min(S5_CHUNK, length)
    u_chunks = jnp.moveaxis(u.reshape(bsz, length // chunk, chunk, S5_GROUPS, S5_GROUP), 1, 0)

    def step(carry, uk):
        hr, hi = carry
        xr = jnp.einsum('gph,btgh->btgp', bb_re, uk)
        xi = jnp.einsum('gph,btgh->btgp', bb_im, uk)
        ar = jnp.broadcast_to(a_re, xr.shape)
        ai = jnp.broadcast_to(a_im, xr.shape)
        cr, ci, sr, si = lax.associative_scan(_complex_affine_combine, (ar, ai, xr, xi), axis=1)
        st_re = sr + cr * hr[:, None] - ci * hi[:, None]
        st_im = si + cr * hi[:, None] + ci * hr[:, None]
        y = jnp.einsum('ghp,btgp->btgh', c_re, st_re) - jnp.einsum('ghp,btgp->btgh', c_im, st_im)
        return (st_re[:, -1], st_im[:, -1]), y

    (h_re, h_im), ys = lax.scan(step, (h_re, h_im), u_chunks)
    y = jnp.moveaxis(ys, 0, 1).reshape(bsz, length, S5_GROUPS, S5_GROUP)
    return y, h_re, h_im


def _s5_mixer(u_lat, u_ctx, lam_re, lam_im, log_step, b_re, b_im, c_re, c_im, d, w_glu, ctx_out):
    f32 = jnp.float32
    bsz, length, width = u_lat.shape
    ul = u_lat.astype(f32).reshape(bsz, length, S5_GROUPS, S5_GROUP)
    uc = u_ctx.astype(f32).reshape(bsz, u_ctx.shape[1], S5_GROUPS, S5_GROUP)
    h0 = jnp.zeros((bsz, S5_GROUPS, S5_STATE), f32)

    def direction(k):
        return tuple(p[k].astype(f32) for p in (lam_re, lam_im, log_step, b_re, b_im, c_re, c_im))

    fwd, bwd = direction(0), direction(1)
    yc_f, hr, hi = _s5_scan(uc, *fwd, h0, h0)
    yl_f, _, _ = _s5_scan(ul, *fwd, hr, hi)
    yc_b, hr, hi = _s5_scan(uc[:, ::-1], *bwd, h0, h0)
    yl_b, _, _ = _s5_scan(ul[:, ::-1], *bwd, hr, hi)
    d_f = d.astype(f32).reshape(S5_GROUPS, S5_GROUP)

    def glu(y, u, dtype):
        g = jax.nn.gelu(y + d_f * u).reshape(bsz, -1, width).astype(dtype)
        a, gate = jnp.split(g @ w_glu, 2, axis=-1)
        return a * jax.nn.sigmoid(gate)

    y_lat = glu(yl_f + yl_b[:, ::-1], ul, u_lat.dtype)
    y_ctx = glu(yc_f + yc_b[:, ::-1], uc, u_ctx.dtype) if ctx_out else None
    return y_lat, y_ctx


def _project_heads(u, w_qkv, n_q, n_kv, q_gain, k_gain, with_q=True):
    bsz, length, _ = u.shape
    q_width = n_q * HEAD_DIM
    if with_q:
        h = u @ w_qkv
        q = _rmsnorm(h[..., :q_width].reshape(bsz, length, n_q, HEAD_DIM), q_gain)
        kv = h[..., q_width:]
    else:
        q = None
        kv = u @ w_qkv[:, q_width:]
    k, v = jnp.split(kv, 2, axis=-1)
    k = _rmsnorm(k.reshape(bsz, length, n_kv, HEAD_DIM), k_gain)
    v = v.reshape(bsz, length, n_kv, HEAD_DIM)
    return q, k, v


def _context_attention(qc, kc, vc, sinks):
    s = jnp.einsum('bqhgd,bkhd->bhgqk', qc, kc).astype(jnp.float32) * HEAD_DIM ** -0.5
    if sinks is not None:
        sink = jnp.broadcast_to(sinks.astype(jnp.float32)[None, :, :, None, None], s.shape[:-1] + (1,))
        s = jnp.concatenate([s, sink], axis=-1)
    p = jax.nn.softmax(s, axis=-1)
    if sinks is not None:
        p = p[..., :-1]
    o = jnp.einsum('bhgqk,bkhd->bqhgd', p.astype(vc.dtype), vc)
    return o.reshape(o.shape[0], o.shape[1], -1)


def _swa_mixer(u_lat, u_ctx, w_qkv, w_o, q_gain, k_gain, sinks, ctx_out):
    bsz, length, _ = u_lat.shape
    grp = SWA_HEADS // SWA_KV_HEADS
    win, blk = SWA_WINDOW, SWA_BLOCK
    n_keys = blk + 2 * win
    scale = HEAD_DIM ** -0.5
    q, k, v = _project_heads(u_lat, w_qkv, SWA_HEADS, SWA_KV_HEADS, q_gain, k_gain)
    t = jnp.arange(length)
    q = _axial_rope(q, t // GRID_W, t % GRID_W)
    k = _axial_rope(k, t // GRID_W, t % GRID_W)
    qc, kc, vc = _project_heads(u_ctx, w_qkv, SWA_HEADS, SWA_KV_HEADS, q_gain, k_gain, with_q=ctx_out)
    q = q.reshape(bsz, length, SWA_KV_HEADS, grp, HEAD_DIM)
    sink = sinks.astype(jnp.float32).reshape(SWA_KV_HEADS, grp)
    pad = ((0, 0), (win, win), (0, 0), (0, 0))
    kp = jnp.pad(k, pad)
    vp = jnp.pad(v, pad)
    kk = jnp.arange(n_keys)
    qq = jnp.arange(blk)
    rel = kk[None, :] - qq[:, None]
    band = (rel >= 0) & (rel <= 2 * win)

    def block(b):
        start = b * blk
        qb = lax.dynamic_slice_in_dim(q, start, blk, axis=1)
        kb = lax.dynamic_slice_in_dim(kp, start, n_keys, axis=1)
        vb = lax.dynamic_slice_in_dim(vp, start, n_keys, axis=1)
        pos = start - win + kk
        valid = band & ((pos >= 0) & (pos < length))[None, :]
        s_loc = jnp.einsum('bqhgd,bkhd->bhgqk', qb, kb).astype(jnp.float32) * scale
        s_loc = jnp.where(valid, s_loc, NEG_INF)
        s_ctx = jnp.einsum('bqhgd,bchd->bhgqc', qb, kc).astype(jnp.float32) * scale
        s_sink = jnp.broadcast_to(sink[None, :, :, None, None], s_ctx.shape[:-1] + (1,))
        p = jax.nn.softmax(jnp.concatenate([s_loc, s_ctx, s_sink], axis=-1), axis=-1).astype(vb.dtype)
        return (jnp.einsum('bhgqk,bkhd->bqhgd', p[..., :n_keys], vb)
                + jnp.einsum('bhgqc,bchd->bqhgd', p[..., n_keys:-1], vc))

    o = lax.map(block, jnp.arange(length // blk))
    o = jnp.moveaxis(o, 0, 1).reshape(bsz, length, SWA_HEADS * HEAD_DIM)
    y_lat = o @ w_o
    y_ctx = None
    if ctx_out:
        qc = qc.reshape(bsz, qc.shape[1], SWA_KV_HEADS, grp, HEAD_DIM)
        y_ctx = _context_attention(qc, kc, vc, sink) @ w_o
    return y_lat, y_ctx


def _na_mixer(u_lat, u_ctx, w_qkv, w_o, q_gain, k_gain, rpb, ctx_out):
    bsz, length, _ = u_lat.shape
    n_heads = NA_HEADS
    n_rows = length // GRID_W
    kr_size = min(NA_WIN_ROWS, n_rows)
    kc_size = NA_WIN_COLS
    scale = HEAD_DIM ** -0.5
    q, k, v = _project_heads(u_lat, w_qkv, n_heads, n_heads, q_gain, k_gain)
    qc, kc, vc = _project_heads(u_ctx, w_qkv, n_heads, n_heads, q_gain, k_gain, with_q=ctx_out)
    qg = q.reshape(bsz, n_rows, GRID_W, n_heads, HEAD_DIM)
    kg = k.reshape(bsz, n_rows, GRID_W, n_heads, HEAD_DIM)
    vg = v.reshape(bsz, n_rows, GRID_W, n_heads, HEAD_DIM)
    col = jnp.arange(GRID_W)
    c0 = jnp.clip(col - kc_size // 2, 0, GRID_W - kc_size)
    col_mask = (col[None, :] >= c0[:, None]) & (col[None, :] < c0[:, None] + kc_size)
    col_idx = jnp.clip(col[None, :] - col[:, None] + kc_size - 1, 0, 2 * kc_size - 2)
    bias_cols = rpb.astype(jnp.float32)[:, :, col_idx]
    mask5 = col_mask[None, None, :, None, :]
    n_loc = kr_size * GRID_W

    def row_block(r):
        r0 = jnp.clip(r - kr_size // 2, 0, n_rows - kr_size)
        qr = lax.dynamic_index_in_dim(qg, r, axis=1, keepdims=False)
        kr = lax.dynamic_slice_in_dim(kg, r0, kr_size, axis=1)
        vr = lax.dynamic_slice_in_dim(vg, r0, kr_size, axis=1)
        row_idx = r0 + jnp.arange(kr_size) - r + NA_WIN_ROWS - 1
        bias = jnp.transpose(jnp.take(bias_cols, row_idx, axis=1), (0, 2, 1, 3))
        s_loc = jnp.einsum('bqhd,bakhd->bhqak', qr, kr).astype(jnp.float32) * scale + bias[None]
        s_loc = jnp.where(mask5, s_loc, NEG_INF).reshape(bsz, n_heads, GRID_W, n_loc)
        s_ctx = jnp.einsum('bqhd,bchd->bhqc', qr, kc).astype(jnp.float32) * scale
        p = jax.nn.softmax(jnp.concatenate([s_loc, s_ctx], axis=-1), axis=-1).astype(vr.dtype)
        p_loc = p[..., :n_loc].reshape(bsz, n_heads, GRID_W, kr_size, GRID_W)
        return (jnp.einsum('bhqak,bakhd->bqhd', p_loc, vr)
                + jnp.einsum('bhqc,bchd->bqhd', p[..., n_loc:], vc))

    o = lax.map(row_block, jnp.arange(n_rows))
    o = jnp.moveaxis(o, 0, 1).reshape(bsz, length, n_heads * HEAD_DIM)
    y_lat = o @ w_o
    y_ctx = None
    if ctx_out:
        qc = qc.reshape(bsz, qc.shape[1], n_heads, 1, HEAD_DIM)
        y_ctx = _context_attention(qc, kc, vc, None) @ w_o
    return y_lat, y_ctx


def setup_inputs(seed: int = 0) -> dict:
    key = jax.random.key(seed)
    ks = iter(jax.random.split(key, 40))
    f32 = jnp.float32

    def nrm(shape, s):
        return jax.random.normal(next(ks), shape, f32) * s

    D = D_MODEL
    G, P, H = S5_GROUPS, S5_STATE, S5_GROUP
    swa_cols = (SWA_HEADS + 2 * SWA_KV_HEADS) * HEAD_DIM
    na_cols = 3 * NA_HEADS * HEAD_DIM
    return {
        'x': nrm((BATCH, SEQ, D), 1.0),
        'c': nrm((BATCH, D), 1.0),
        'ctx': nrm((BATCH, CTX_LEN, D), 1.0),
        'c_ctx': nrm((D,), 1.0),
        'ada_down': nrm((DEPTH, D, ADA_RANK), D ** -0.5),
        'ada_up': nrm((DEPTH, ADA_RANK, 6 * D), 0.5 * ADA_RANK ** -0.5),
        'ada_b': nrm((DEPTH, 6 * D), 0.02),
        'norm_mix': 1.0 + nrm((DEPTH, D), 0.02),
        'norm_ffn': 1.0 + nrm((DEPTH, D), 0.02),
        'ffn_w_gate_up': nrm((DEPTH, D, 2 * D_FF), D ** -0.5),
        'ffn_w_down': nrm((DEPTH, D_FF, D), D_FF ** -0.5),
        'pool_w': nrm((len(POOL_WINDOWS), POOL_GROUP, POOL_GROUP), POOL_GROUP ** -0.5),
        'pool_scale': 1.0 + nrm((D,), 0.02),
        's5_lam_re': -0.5 + nrm((2, G, P), 0.01),
        's5_lam_im': math.pi * jnp.arange(P, dtype=f32) + nrm((2, G, P), 0.01),
        's5_log_step': jax.random.uniform(next(ks), (2, G), f32, math.log(1e-3), math.log(1e-1)),
        's5_b_re': nrm((2, G, P, H), (2 * H) ** -0.5),
        's5_b_im': nrm((2, G, P, H), (2 * H) ** -0.5),
        's5_c_re': nrm((2, G, H, P), P ** -0.5),
        's5_c_im': nrm((2, G, H, P), P ** -0.5),
        's5_d': nrm((D,), 1.0),
        's5_w_glu': nrm((D, 2 * D), D ** -0.5),
        'swa_w_qkv': nrm((D, swa_cols), D ** -0.5),
        'swa_w_o': nrm((SWA_HEADS * HEAD_DIM, D), (SWA_HEADS * HEAD_DIM) ** -0.5),
        'swa_q_gain': 1.0 + nrm((HEAD_DIM,), 0.02),
        'swa_k_gain': 1.0 + nrm((HEAD_DIM,), 0.02),
        'swa_sinks': nrm((SWA_HEADS,), 1.0),
        'na_w_qkv': nrm((D, na_cols), D ** -0.5),
        'na_w_o': nrm((NA_HEADS * HEAD_DIM, D), (NA_HEADS * HEAD_DIM) ** -0.5),
        'na_q_gain': 1.0 + nrm((HEAD_DIM,), 0.02),
        'na_k_gain': 1.0 + nrm((HEAD_DIM,), 0.02),
        'na_rpb': nrm((NA_HEADS, 2 * NA_WIN_ROWS - 1, 2 * NA_WIN_COLS - 1), 0.1),
    }


def reference(x, c, ctx, c_ctx, ada_down, ada_up, ada_b, norm_mix, norm_ffn, ffn_w_gate_up, ffn_w_down,
              pool_w, pool_scale, s5_lam_re, s5_lam_im, s5_log_step, s5_b_re, s5_b_im, s5_c_re, s5_c_im,
              s5_d, s5_w_glu, swa_w_qkv, swa_w_o, swa_q_gain, swa_k_gain, swa_sinks,
              na_w_qkv, na_w_o, na_q_gain, na_k_gain, na_rpb):
    for i in range(DEPTH):
        kind = i % N_MIXERS
        last = i == DEPTH - 1
        mod_x = _adaln(c, ada_down[i], ada_up[i], ada_b[i])[:, :, None, :]
        mod_c = _adaln(c_ctx, ada_down[i], ada_up[i], ada_b[i])
        ul = _modulate(_rmsnorm(x, norm_mix[i]), mod_x[:, 0], mod_x[:, 1])
        uc = _modulate(_rmsnorm(ctx, norm_mix[i]), mod_c[0], mod_c[1])
        if kind == 0:
            yl = _pool_mixer(ul, pool_w, pool_scale)
            yc = None if last else _pool_mixer(uc, pool_w, pool_scale)
        elif kind == 1:
            yl, yc = _s5_mixer(ul, uc, s5_lam_re, s5_lam_im, s5_log_step, s5_b_re, s5_b_im,
                               s5_c_re, s5_c_im, s5_d, s5_w_glu, not last)
        elif kind == 2:
            yl, yc = _swa_mixer(ul, uc, swa_w_qkv, swa_w_o, swa_q_gain, swa_k_gain, swa_sinks, not last)
        else:
            yl, yc = _na_mixer(ul, uc, na_w_qkv, na_w_o, na_q_gain, na_k_gain, na_rpb, not last)
        x = x + mod_x[:, 2] * yl
        hx = _modulate(_rmsnorm(x, norm_ffn[i]), mod_x[:, 3], mod_x[:, 4])
        x = x + mod_x[:, 5] * _swiglu(hx, ffn_w_gate_up[i], ffn_w_down[i])
        if not last:
            ctx = ctx + mod_c[2] * yc
            hc = _modulate(_rmsnorm(ctx, norm_ffn[i]), mod_c[3], mod_c[4])
            ctx = ctx + mod_c[5] * _swiglu(hc, ffn_w_gate_up[i], ffn_w_down[i])
    return x
```

```cpp
#include <hip/hip_runtime.h>
#include <cstdio>
#include <cstdint>

#define GAS __attribute__((address_space(1)))
#define LAS __attribute__((address_space(3)))
typedef unsigned short bf16;
typedef short bf16x8 __attribute__((ext_vector_type(8)));
typedef float f32x4 __attribute__((ext_vector_type(4)));
typedef float f32x2 __attribute__((ext_vector_type(2)));
typedef float f32x16 __attribute__((ext_vector_type(16)));
typedef unsigned u32x4 __attribute__((ext_vector_type(4)));
typedef unsigned u32x2 __attribute__((ext_vector_type(2)));
typedef __bf16 bf16x2_t __attribute__((ext_vector_type(2)));

#ifndef MK_PER_PHASE
#define MK_PER_PHASE 0
#endif
#ifndef PROF_SET
#define PROF_SET 0
#endif
#ifndef MK_LAST_PHASE
#define MK_LAST_PHASE 1000
#endif

constexpr int D = 4096, SEQ = 8192, CTXL = 256, MT = SEQ + CTXL, DFF = 11008, RANK = 1024, NWAVES = 8;
constexpr float RMS_EPS = 1e-6f;
constexpr float LOG2E = 1.4426950408889634f;
constexpr float QSCALE = 0.08838834764831845f * LOG2E;

constexpr size_t MiB = 1u << 20;
constexpr size_t WS_CTL = 0, CTL_ZERO_BYTES = 1 * MiB;
constexpr size_t WS_MOD = 1 * MiB;
constexpr size_t WS_HIDP = 2 * MiB;
constexpr size_t WS_ROPE = 3 * MiB;
constexpr size_t WS_X = 4 * MiB;
constexpr size_t WS_U = 136 * MiB;
constexpr size_t WS_P = 202 * MiB;
constexpr size_t WS_H = 268 * MiB;
constexpr size_t WS_QK = 446 * MiB;
constexpr size_t WS_VT = 578 * MiB;
constexpr size_t WS_HC = 644 * MiB;
constexpr size_t WS_HLOC = 776 * MiB;
constexpr size_t WS_MF = 908 * MiB;
constexpr size_t WS_EG = 972 * MiB;
constexpr size_t WS_WGU = 1024 * MiB;
constexpr size_t WS_WDN = 1712 * MiB;
constexpr size_t WS_WPOOL = 2056 * MiB;
constexpr size_t WS_WGLU = 2064 * MiB;
constexpr size_t WS_WSQKV = 2128 * MiB;
constexpr size_t WS_WSO = 2176 * MiB;
constexpr size_t WS_WNQKV = 2208 * MiB;
constexpr size_t WS_WNO = 2304 * MiB;
constexpr size_t WS_SLAB = 2336 * MiB;
constexpr size_t WS_END = 2408 * MiB;
constexpr int CW_BAR = 4096;

constexpr int RING_OFF = 0, RING_BYTES = 131072;
constexpr int MISC_OFF = RING_BYTES;
constexpr int LDS_BYTES = 147456;

#define LDS_WAIT() asm volatile("s_waitcnt lgkmcnt(0)" ::: "memory")
#define VM_WAIT() asm volatile("s_waitcnt vmcnt(0)" ::: "memory")

__device__ __forceinline__ unsigned pk2(float lo, float hi) { f32x2 v = {lo, hi}; bf16x2_t b = __builtin_convertvector(v, bf16x2_t); return __builtin_bit_cast(unsigned, b); }
__device__ __forceinline__ float bf2f(unsigned short b) { return __uint_as_float(((unsigned)b) << 16); }
__device__ __forceinline__ float bflo(unsigned w) { return __uint_as_float(w << 16); }
__device__ __forceinline__ float bfhi(unsigned w) { return __uint_as_float(w & 0xffff0000u); }
__device__ __forceinline__ float wave_sum(float v) {
#pragma unroll
    for (int o = 1; o < 64; o <<= 1) v += __shfl_xor(v, o);
    return v;
}
__device__ __forceinline__ float fast_sigmoid(float a) { return __frcp_rn(1.0f + __expf(-a)); }
__device__ __forceinline__ float silu_f(float a) { return a * fast_sigmoid(a); }

#define XB_TMO      128
#define XB_XCNT(j)  (256  + 64 * (j))
#define XB_XSUB(j)  (1280 + 64 * (j))
#define XB_XGEN(j)  (2304 + 64 * (j))
#define XB_TOP      3328
#define XB_TOPGEN   3392
#define XCD_BAR_WORDS 3456
#define XB_SPIN_CAP (1u << 23)

__device__ __forceinline__ unsigned xb_ld(unsigned* p)              { return __hip_atomic_load(p, __ATOMIC_RELAXED, __HIP_MEMORY_SCOPE_AGENT); }
__device__ __forceinline__ unsigned xb_add(unsigned* p, unsigned v) { return __hip_atomic_fetch_add(p, v, __ATOMIC_RELAXED, __HIP_MEMORY_SCOPE_AGENT); }
__device__ __forceinline__ unsigned xb_xcc_id() { return (unsigned)__builtin_amdgcn_s_getreg((3 << 11) | 20) & 0xFu; }
#define XB_SPIN(cond, bar) do { unsigned _sp = 0; while (cond) { __builtin_amdgcn_s_sleep(1); \
    if ((++_sp & 255u) == 0u) { if (xb_ld(&(bar)[XB_TMO])) break; if (_sp > XB_SPIN_CAP) { atomicAdd(&(bar)[XB_TMO], 1u); break; } } } } while (0)

struct XcdBarrier { unsigned* bar; unsigned x; volatile LAS unsigned* st; };

__device__ __forceinline__ XcdBarrier xcd_barrier_post(unsigned* bar, volatile LAS unsigned* st) {
    XcdBarrier b; b.bar = bar; b.x = xb_xcc_id(); b.st = st;
    if (threadIdx.x == 0) (void)xb_add(&bar[XB_XCNT(b.x)], 1u);
    return b;
}
__device__ __forceinline__ void xcd_barrier_complete(unsigned* bar, unsigned x, unsigned& nloc, unsigned& nx) {
    const unsigned G = gridDim.x * gridDim.y * gridDim.z;
    unsigned sum, cnt, mine, sp = 0u;
    for (;;) {
        sum = 0u; cnt = 0u; mine = 0u;
#pragma unroll
        for (unsigned j = 0; j < 16; ++j) { const unsigned c = xb_ld(&bar[XB_XCNT(j)]); sum += c; cnt += (c > 0u) ? 1u : 0u; mine = (j == x) ? c : mine; }
        if (sum == G) break;
        __builtin_amdgcn_s_sleep(1);
        if ((++sp & 255u) == 0u) { if (xb_ld(&bar[XB_TMO])) break; if (sp > XB_SPIN_CAP) { atomicAdd(&bar[XB_TMO], 1u); break; } }
    }
    nloc = mine > 0u ? mine : 1u; nx = cnt > 0u ? cnt : 1u;
}
__device__ __forceinline__ void xcd_barrier(const XcdBarrier& b) {
    asm volatile("s_waitcnt vmcnt(0)" ::: "memory");
    __syncthreads();
    if (threadIdx.x == 0) {
        unsigned* bar = b.bar;
        __builtin_amdgcn_s_waitcnt(0);
        unsigned nloc = b.st[0], nx = b.st[1];
        if (nloc == 0u) { xcd_barrier_complete(bar, b.x, nloc, nx); b.st[0] = nloc; b.st[1] = nx; }
        const unsigned old = xb_add(&bar[XB_XSUB(b.x)], 1u);
        const unsigned gen = old / nloc;
        if (old + 1u == (gen + 1u) * nloc) {
            __builtin_amdgcn_fence(__ATOMIC_RELEASE, "agent");
            asm volatile("s_waitcnt vmcnt(0)" ::: "memory");
            const unsigned og = xb_add(&bar[XB_TOP], 1u);
            const unsigned tg = og / nx;
            if (og + 1u == (tg + 1u) * nx) xb_add(&bar[XB_TOPGEN], 1u);
            else XB_SPIN(xb_ld(&bar[XB_TOPGEN]) == tg, bar);
            __builtin_amdgcn_fence(__ATOMIC_ACQUIRE, "agent");
            xb_add(&bar[XB_XGEN(b.x)], 1u);
            asm volatile("s_waitcnt vmcnt(0)" ::: "memory");
        } else {
            XB_SPIN(xb_ld(&bar[XB_XGEN(b.x)]) == gen, bar);
            __builtin_amdgcn_fence(__ATOMIC_ACQUIRE, "agent");
            asm volatile("s_waitcnt vmcnt(0)" ::: "memory");
        }
    }
    __syncthreads();
}

namespace pg8 {
constexpr int BM = 256, BK = 64, HALF = 128, HTB = HALF * BK * 2, STAGE_BYTES = 8 * HTB, NXCD = 8, WGM = 8;
__host__ __device__ __forceinline__ int lds_byte(int r, int c) { const int st = (r >> 4) * 2 + (c >> 5), rr = r & 15, cc = c & 31, ob = rr * 64 + cc * 2; return st * 1024 + (ob ^ (((ob >> 9) & 1) << 5)); }
__host__ __device__ __forceinline__ void stage_rc(int b, int& R, int& C) { const int st = b / 1024, sb = b % 1024, swz = sb ^ (((sb >> 9) & 1) << 5); R = (st >> 1) * 16 + swz / 64; C = (st & 1) * 32 + (swz % 64) / 2; }
__host__ __device__ __forceinline__ int perm32(int rho) { const int n = rho >> 4, i = rho & 15; return 8 * (i >> 2) + 4 * n + (i & 3); }

struct Unit { int pm, pn, kt0, sidx, which; };
struct Gemm { const bf16* A; long lda; const bf16* Bt; long ldb; int nM, nN, K; long agrp; const bf16* A2; const bf16* Bt2; };

struct StaticOrder {
    int nM, nN, nwg, G, c, first, count, SF, kofs, nkt, nM2, nN2, nwg2;
    __host__ __device__ void init(int nM_, int nN_, int G_, int c_, int first_ = 0, int count_ = -1, int SF_ = 1, int kofs_ = 0, int nkt_ = 0) {
        nM = nM_; nN = nN_; nwg = nM * nN; G = G_; c = c_; first = first_; count = count_ < 0 ? nwg : count_; SF = SF_; kofs = kofs_; nkt = nkt_; nM2 = 0; nN2 = 1; nwg2 = 0; }
    __host__ __device__ void init2(int nM2_, int nN2_) { nM2 = nM2_; nN2 = nN2_; nwg2 = nM2 * nN2; }
    __host__ __device__ static void tile_of(int wgid, int nwg_, int nM_, int nN_, Unit& u) {
        { const int q = nwg_ / NXCD, r = nwg_ % NXCD, xcd = wgid % NXCD, off = wgid / NXCD; wgid = (xcd < r ? xcd * (q + 1) : r * (q + 1) + (xcd - r) * q) + off; }
        const int nig = WGM * nN_, gid = wgid / nig, fm = gid * WGM, gsz = (nM_ - fm) < WGM ? (nM_ - fm) : WGM;
        u.pm = fm + ((wgid % nig) % gsz); u.pn = (wgid % nig) / gsz; }
    __host__ __device__ bool next(int i, Unit& u) const {
        const long idx = (long)i * G + c; u.which = 0;
        if (idx >= (long)count * SF) { const long j = idx - (long)count * SF; if (j >= nwg2) return false; u.which = 1; u.kt0 = 0; u.sidx = 0; tile_of((int)j, nwg2, nM2, nN2, u); return true; }
        u.sidx = (int)(idx % SF); u.kt0 = kofs + u.sidx * nkt; tile_of(first + (int)(idx / SF), nwg, nM, nN, u); return true;
    }
};

template <class Epi, bool ALIGN_EPI = true>
__device__ __forceinline__ void gemm_phase(LAS unsigned char* lds, const Gemm g, const StaticOrder& S, const Epi& E) {
    const int tid = threadIdx.x, wid = __builtin_amdgcn_readfirstlane(tid >> 6), lane = tid & 63, wr = wid >> 2, wc = wid & 3, fr = lane & 15, fq = lane >> 4;
    const int nt = g.K / BK;
    unsigned voffA[2], voffB[2];
#pragma unroll
    for (int i = 0; i < 2; ++i) { int R, C; stage_rc(tid * 16 + i * 8192, R, C); const int Rb = Epi::PERM ? ((R & ~31) + perm32(R & 31)) : R;
        voffA[i] = (unsigned)((long)R * g.lda + C) * 2u; voffB[i] = (unsigned)((long)Rb * g.ldb + C) * 2u; }
    const size_t kstep = (size_t)(BK * 2);
    const size_t hstepA = (size_t)HALF * g.lda * 2, hstepB = (size_t)HALF * g.ldb * 2;
    const size_t tstepA = 2 * hstepA, tstepB = 2 * hstepB;
    const unsigned ldsw = (unsigned)wid * 1024u;
    const int aoff = lds_byte(wr * 64 + fr, fq * 8), boff = lds_byte(wc * 32 + fr, fq * 8);
#define PG8_SA(b, h) (((b) * 2 + (h)) * HTB)
#define PG8_SB(b, h) ((4 + (b) * 2 + (h)) * HTB)
#define PG8_STAGE(bufoff, gbase, voff) do { _Pragma("unroll") for (int _i = 0; _i < 2; ++_i) \
        __builtin_amdgcn_global_load_lds((const unsigned*)((const char*)(gbase) + (voff)[_i]), (LAS unsigned*)(lds + (bufoff) + ldsw + _i * 8192), 16, 0, 0); } while (0)
#define PG8_LDA(dst, b, h) do { _Pragma("unroll") for (int m = 0; m < 4; ++m) _Pragma("unroll") for (int k = 0; k < 2; ++k) dst[m][k] = *(const LAS bf16x8*)(lds + PG8_SA(b, h) + aoff + m * 2048 + k * 1024); } while (0)
#define PG8_LDB(dst, b, h) do { _Pragma("unroll") for (int n = 0; n < 2; ++n) _Pragma("unroll") for (int k = 0; k < 2; ++k) dst[n][k] = *(const LAS bf16x8*)(lds + PG8_SB(b, h) + boff + n * 2048 + k * 1024); } while (0)
#define PG8_MMA(ai, bj, At, Bt) do { __builtin_amdgcn_s_setprio(1); _Pragma("unroll") for (int m = 0; m < 4; ++m) _Pragma("unroll") for (int n = 0; n < 2; ++n) _Pragma("unroll") for (int k = 0; k < 2; ++k) \
        acc[ai][bj][m][n] = __builtin_amdgcn_mfma_f32_16x16x32_bf16(Bt[n][k], At[m][k], acc[ai][bj][m][n], 0, 0, 0); __builtin_amdgcn_s_setprio(0); } while (0)
#define PG8_WAIT_V(n) asm volatile("s_waitcnt vmcnt(" #n ")" ::: "memory")
#define PG8_WAIT_L(n) asm volatile("s_waitcnt lgkmcnt(" #n ")" ::: "memory")
#define PG8_BAR __builtin_amdgcn_s_barrier()
#define PG8_SCHED __builtin_amdgcn_sched_barrier(0)
    Unit cur, nxt; int ui = 0;
    if (!S.next(0, cur)) return;
    f32x4 acc[2][2][4][2];
#pragma unroll
    for (int a = 0; a < 2; ++a)
#pragma unroll
        for (int b = 0; b < 2; ++b)
#pragma unroll
            for (int m = 0; m < 4; ++m)
#pragma unroll
                for (int n = 0; n < 2; ++n) acc[a][b][m][n] = (f32x4){0.f, 0.f, 0.f, 0.f};
    bf16x8 At[4][2], B0[2][2], B1[2][2];
    const char* cA = (const char*)(cur.which ? g.A2 : g.A) + (size_t)cur.pm * tstepA + (size_t)(cur.pn >> 2) * g.agrp + (size_t)cur.kt0 * kstep; const char* cB = (const char*)(cur.which ? g.Bt2 : g.Bt) + (size_t)cur.pn * tstepB + (size_t)cur.kt0 * kstep;
    PG8_STAGE(PG8_SB(0, 0), cB, voffB); PG8_STAGE(PG8_SB(0, 1), cB + hstepB, voffB); PG8_STAGE(PG8_SA(0, 0), cA, voffA); PG8_STAGE(PG8_SA(0, 1), cA + hstepA, voffA);
    if (wr == 1) PG8_BAR;
    PG8_WAIT_V(2); PG8_BAR;
    PG8_STAGE(PG8_SB(1, 0), cB + kstep, voffB); PG8_STAGE(PG8_SA(1, 0), cA + kstep, voffA); PG8_STAGE(PG8_SB(1, 1), cB + hstepB + kstep, voffB);
    PG8_WAIT_V(6); PG8_BAR;
    for (;;) {
        const bool has_next = S.next(ui + 1, nxt);
        const char* nA = has_next ? (const char*)(nxt.which ? g.A2 : g.A) + (size_t)nxt.pm * tstepA + (size_t)(nxt.pn >> 2) * g.agrp + (size_t)nxt.kt0 * kstep : cA; const char* nB = has_next ? (const char*)(nxt.which ? g.Bt2 : g.Bt) + (size_t)nxt.pn * tstepB + (size_t)nxt.kt0 * kstep : cB;
        for (int t = 0; t < nt; t += 2) {
            const bool last = (t == nt - 2);
            const char* a1 = cA + (size_t)(t + 1) * kstep;
            const char* a2 = last ? nA : cA + (size_t)(t + 2) * kstep; const char* b2 = last ? nB : cB + (size_t)(t + 2) * kstep;
            const char* a3 = a2 + kstep; const char* b3 = b2 + kstep;
            PG8_LDB(B0, 0, 0); PG8_LDB(B1, 0, 1); PG8_SCHED; PG8_LDA(At, 0, 0); PG8_STAGE(PG8_SA(1, 1), a1 + hstepA, voffA);
            PG8_WAIT_V(8); PG8_WAIT_L(0); PG8_BAR; PG8_MMA(0, 0, At, B0); PG8_MMA(0, 1, At, B1); PG8_BAR; PG8_SCHED;
            PG8_LDA(At, 0, 1); PG8_STAGE(PG8_SB(0, 0), b2, voffB); PG8_STAGE(PG8_SB(0, 1), b2 + hstepB, voffB); PG8_STAGE(PG8_SA(0, 0), a2, voffA);
            PG8_WAIT_V(8); PG8_WAIT_L(0); PG8_BAR; PG8_MMA(1, 0, At, B0); PG8_MMA(1, 1, At, B1); PG8_BAR; PG8_SCHED;
            PG8_LDB(B0, 1, 0); PG8_LDB(B1, 1, 1); PG8_SCHED; PG8_LDA(At, 1, 0); PG8_STAGE(PG8_SA(0, 1), a2 + hstepA, voffA);
            PG8_WAIT_V(8); PG8_WAIT_L(0); PG8_BAR; PG8_MMA(0, 0, At, B0); PG8_MMA(0, 1, At, B1); PG8_BAR; PG8_SCHED;
            PG8_LDA(At, 1, 1); PG8_STAGE(PG8_SB(1, 0), b3, voffB); PG8_STAGE(PG8_SB(1, 1), b3 + hstepB, voffB); PG8_STAGE(PG8_SA(1, 0), a3, voffA);
            PG8_WAIT_V(8); PG8_WAIT_L(0); PG8_BAR; PG8_MMA(1, 0, At, B0); PG8_MMA(1, 1, At, B1); PG8_BAR; PG8_SCHED;
        }
        if constexpr (ALIGN_EPI) { if (wr == 0) PG8_BAR; }
        E(acc, cur, wr, wc, fr, fq);
        if (!has_next) break;
#pragma unroll
        for (int a = 0; a < 2; ++a)
#pragma unroll
            for (int b = 0; b < 2; ++b)
#pragma unroll
                for (int m = 0; m < 4; ++m)
#pragma unroll
                    for (int n = 0; n < 2; ++n) acc[a][b][m][n] = (f32x4){0.f, 0.f, 0.f, 0.f};
        cur = nxt; cA = nA; cB = nB; ++ui;
        if constexpr (ALIGN_EPI) { if (wr == 1) PG8_BAR; }
    }
    PG8_WAIT_V(0);
    if constexpr (!ALIGN_EPI) { if (wr == 0) PG8_BAR; }
    PG8_BAR;
#undef PG8_SA
#undef PG8_SB
#undef PG8_STAGE
#undef PG8_LDA
#undef PG8_LDB
#undef PG8_MMA
#undef PG8_WAIT_V
#undef PG8_WAIT_L
#undef PG8_BAR
#undef PG8_SCHED
}

struct EpiBf16 {
    static constexpr bool PERM = true;
    bf16* O; long ldc;
    __device__ __forceinline__ void operator()(const f32x4 (&acc)[2][2][4][2], const Unit& u, int wr, int wc, int fr, int fq) const {
        const int row0 = u.pm * BM + wr * 64 + fr, col0 = u.pn * BM + wc * 32 + 8 * fq;
#pragma unroll
        for (int ai = 0; ai < 2; ++ai)
#pragma unroll
            for (int m = 0; m < 4; ++m) { bf16* rowp = O + (size_t)(row0 + ai * HALF + m * 16) * ldc + col0;
#pragma unroll
                for (int bj = 0; bj < 2; ++bj) { const f32x4 v0 = acc[ai][bj][m][0], v1 = acc[ai][bj][m][1];
                    u32x4 w; w.x = pk2(v0[0], v0[1]); w.y = pk2(v0[2], v0[3]); w.z = pk2(v1[0], v1[1]); w.w = pk2(v1[2], v1[3]);
                    *(u32x4*)(rowp + bj * HALF) = w; } }
    }
};
struct EpiSwiGLU {
    static constexpr bool PERM = true;
    bf16* H; long ldh;
    __device__ __forceinline__ void operator()(const f32x4 (&acc)[2][2][4][2], const Unit& u, int wr, int wc, int fr, int fq) const {
        const int row0 = u.pm * BM + wr * 64 + fr, col0 = u.pn * HALF + wc * 32 + 8 * fq;
#pragma unroll
        for (int ai = 0; ai < 2; ++ai)
#pragma unroll
            for (int m = 0; m < 4; ++m) { bf16* rowp = H + (size_t)(row0 + ai * HALF + m * 16) * ldh + col0;
                float h[8];
#pragma unroll
                for (int n = 0; n < 2; ++n)
#pragma unroll
                    for (int j = 0; j < 4; ++j) h[4 * n + j] = silu_f(acc[ai][0][m][n][j]) * acc[ai][1][m][n][j];
                u32x4 w; w.x = pk2(h[0], h[1]); w.y = pk2(h[2], h[3]); w.z = pk2(h[4], h[5]); w.w = pk2(h[6], h[7]);
                *(u32x4*)rowp = w; }
    }
};
struct EpiResid {
    static constexpr bool PERM = false;
    const float* base_lat; const float* base_ctx; float* out_lat; float* out_ctx; const float* gate_lat; const float* gate_ctx; const float* cs; int col_off;
    __device__ __forceinline__ void operator()(const f32x4 (&acc)[2][2][4][2], const Unit& u, int wr, int wc, int fr, int fq) const {
        const bool isc = u.pm >= 32;
        const float* base = isc ? base_ctx : base_lat; float* out = isc ? out_ctx : out_lat; const float* gate = isc ? gate_ctx : gate_lat;
        const int row0 = (isc ? u.pm - 32 : u.pm) * BM + wr * 64 + fr, col0 = col_off + u.pn * BM + wc * 32 + 4 * fq;
        f32x4 gv[2][2];
#pragma unroll
        for (int bj = 0; bj < 2; ++bj)
#pragma unroll
            for (int n = 0; n < 2; ++n) { gv[bj][n] = *(const f32x4*)(gate + col0 + bj * HALF + n * 16); if (cs) gv[bj][n] *= *(const f32x4*)(cs + col0 + bj * HALF + n * 16); }
#pragma unroll
        for (int ai = 0; ai < 2; ++ai)
#pragma unroll
            for (int m = 0; m < 4; ++m) { const size_t off = (size_t)(row0 + ai * HALF + m * 16) * D + col0;
#pragma unroll
                for (int bj = 0; bj < 2; ++bj)
#pragma unroll
                    for (int n = 0; n < 2; ++n) { const f32x4 bs = *(const f32x4*)(base + off + bj * HALF + n * 16); *(f32x4*)(out + off + bj * HALF + n * 16) = bs + gv[bj][n] * acc[ai][bj][m][n]; }
                asm volatile("" ::: "memory"); }
    }
};
struct EpiSlab {
    static constexpr bool PERM = false;
    float* slab; const float* gate; int sbase;
    __device__ __forceinline__ void operator()(const f32x4 (&acc)[2][2][4][2], const Unit& u, int wr, int wc, int fr, int fq) const {
        const int row0 = wr * 64 + fr, col0 = u.pn * BM + wc * 32 + 4 * fq;
        float* out = slab + (size_t)(sbase + u.sidx) * CTXL * D;
        f32x4 gv[2][2];
#pragma unroll
        for (int bj = 0; bj < 2; ++bj)
#pragma unroll
            for (int n = 0; n < 2; ++n) gv[bj][n] = *(const f32x4*)(gate + col0 + bj * HALF + n * 16);
#pragma unroll
        for (int ai = 0; ai < 2; ++ai)
#pragma unroll
            for (int m = 0; m < 4; ++m) { const size_t off = (size_t)(row0 + ai * HALF + m * 16) * D + col0;
#pragma unroll
                for (int bj = 0; bj < 2; ++bj)
#pragma unroll
                    for (int n = 0; n < 2; ++n) *(f32x4*)(out + off + bj * HALF + n * 16) = gv[bj][n] * acc[ai][bj][m][n]; }
    }
};
struct EpiGLU {
    static constexpr bool PERM = false;
    const float* base_lat; const float* base_ctx; float* out_lat; float* out_ctx; const float* gate_lat; const float* gate_ctx;
    __device__ __forceinline__ void operator()(const f32x4 (&acc)[2][2][4][2], const Unit& u, int wr, int wc, int fr, int fq) const {
        const bool isc = u.pm >= 32;
        const float* base = isc ? base_ctx : base_lat; float* out = isc ? out_ctx : out_lat; const float* gate = isc ? gate_ctx : gate_lat;
        const int row0 = (isc ? u.pm - 32 : u.pm) * BM + wr * 64 + fr, col0 = u.pn * HALF + wc * 32 + 4 * fq;
        f32x4 gv[2];
#pragma unroll
        for (int n = 0; n < 2; ++n) gv[n] = *(const f32x4*)(gate + col0 + n * 16);
#pragma unroll
        for (int ai = 0; ai < 2; ++ai)
#pragma unroll
            for (int m = 0; m < 4; ++m) { const size_t off = (size_t)(row0 + ai * HALF + m * 16) * D + col0;
#pragma unroll
                for (int n = 0; n < 2; ++n) { const f32x4 bs = *(const f32x4*)(base + off + n * 16); const f32x4 a = acc[ai][0][m][n], gt = acc[ai][1][m][n]; f32x4 v;
#pragma unroll
                    for (int j = 0; j < 4; ++j) v[j] = a[j] * fast_sigmoid(gt[j]);
                    *(f32x4*)(out + off + n * 16) = bs + gv[n] * v; }
                asm volatile("" ::: "memory"); }
    }
};
template <bool ROPE> struct EpiHeadNorm {
    static constexpr bool PERM = true;
    bf16* O; long ldc; const float* qg; const float* kg; int nq_tiles; const float* ropetab; LAS float* stats; float qscale; bf16* O1; long ldc1;
    __device__ __forceinline__ void operator()(const f32x4 (&acc)[2][2][4][2], const Unit& u, int wr, int wc, int fr, int fq) const {
        const int rloc0 = wr * 64 + fr;
        if (u.which) {
            const int row0p = u.pm * BM + rloc0, col0p = u.pn * BM + wc * 32 + 8 * fq;
#pragma unroll
            for (int ai = 0; ai < 2; ++ai)
#pragma unroll
                for (int m = 0; m < 4; ++m) { bf16* rowp = O1 + (size_t)(row0p + ai * HALF + m * 16) * ldc1 + col0p;
#pragma unroll
                    for (int bj = 0; bj < 2; ++bj) { const f32x4 v0 = acc[ai][bj][m][0], v1 = acc[ai][bj][m][1];
                        u32x4 w; w.x = pk2(v0[0], v0[1]); w.y = pk2(v0[2], v0[3]); w.z = pk2(v1[0], v1[1]); w.w = pk2(v1[2], v1[3]);
                        *(u32x4*)(rowp + bj * HALF) = w; } }
            return;
        }
#pragma unroll
        for (int ai = 0; ai < 2; ++ai)
#pragma unroll
            for (int m = 0; m < 4; ++m)
#pragma unroll
                for (int bj = 0; bj < 2; ++bj) { const f32x4 v0 = acc[ai][bj][m][0], v1 = acc[ai][bj][m][1];
                    float ss = (v0[0] * v0[0] + v0[1] * v0[1]) + (v0[2] * v0[2] + v0[3] * v0[3]) + (v1[0] * v1[0] + v1[1] * v1[1]) + (v1[2] * v1[2] + v1[3] * v1[3]);
                    ss += __shfl_xor(ss, 16); ss += __shfl_xor(ss, 32);
                    if (fq == 0) stats[((ai * HALF + m * 16 + rloc0) * 2 + bj) * 4 + wc] = ss; }
        asm volatile("s_waitcnt lgkmcnt(0)" ::: "memory"); __builtin_amdgcn_s_barrier(); asm volatile("" ::: "memory");
        const bool isq = u.pn < nq_tiles; const float* gain = isq ? qg : kg; const float osc = isq ? qscale : 1.0f;
        const int g = 4 * wc + fq, i0 = 4 * (g & 7);
        float ga[4], gb[4];
#pragma unroll
        for (int j = 0; j < 4; ++j) { if (ROPE) { ga[j] = gain[(g < 8 ? 0 : 64) + i0 + j] * osc; gb[j] = gain[(g < 8 ? 32 : 96) + i0 + j] * osc; } else { ga[j] = gain[8 * g + j] * osc; gb[j] = gain[8 * g + 4 + j] * osc; } }
        const int row0 = u.pm * BM + rloc0, col0 = u.pn * BM + wc * 32 + 8 * fq;
#pragma unroll
        for (int ai = 0; ai < 2; ++ai)
#pragma unroll
            for (int m = 0; m < 4; ++m) { const int row = row0 + ai * HALF + m * 16; bf16* rowp = O + (size_t)row * ldc + col0;
                f32x4 cs = {1.f, 1.f, 1.f, 1.f}, sn = {0.f, 0.f, 0.f, 0.f};
                if (ROPE) { if (row < SEQ) { const int pos = (g < 8) ? (row >> 6) : (row & 63); const float* tp = ropetab + ((size_t)pos * 32 + i0) * 2;
                        const f32x4 t0 = *(const f32x4*)tp, t1 = *(const f32x4*)(tp + 4); cs = (f32x4){t0[0], t0[2], t1[0], t1[2]}; sn = (f32x4){t0[1], t0[3], t1[1], t1[3]}; } }
#pragma unroll
                for (int bj = 0; bj < 2; ++bj) { const f32x4 st = *(const LAS f32x4*)(stats + ((ai * HALF + m * 16 + rloc0) * 2 + bj) * 4);
                    const float rs = rsqrtf(((st[0] + st[1]) + (st[2] + st[3])) * (1.0f / 128.0f) + RMS_EPS);
                    const f32x4 v0 = acc[ai][bj][m][0], v1 = acc[ai][bj][m][1]; float oa[4], ob[4];
#pragma unroll
                    for (int j = 0; j < 4; ++j) { const float ya = v0[j] * rs * ga[j], yb = v1[j] * rs * gb[j];
                        if (ROPE) { oa[j] = ya * cs[j] - yb * sn[j]; ob[j] = yb * cs[j] + ya * sn[j]; } else { oa[j] = ya; ob[j] = yb; } }
                    u32x4 w; w.x = pk2(oa[0], oa[1]); w.y = pk2(oa[2], oa[3]); w.z = pk2(ob[0], ob[1]); w.w = pk2(ob[2], ob[3]);
                    *(u32x4*)(rowp + bj * HALF) = w; } }
    }
};
}

struct Frame {
    LAS unsigned char* lds;
    int tid, lane, wave, vcu, G, gw, NGW;
    const float* in[32];
    float* out; unsigned char* ws; int cvo;
};
struct Args { const float* in[32]; float* out; unsigned char* ws; int ph_lo, ph_hi, li, cvo; };

__device__ __forceinline__ float* modp(const Frame& F, int l, int v, int i) { return (float*)(F.ws + WS_MOD) + ((size_t)(l * 2 + v) * 6 + i) * D; }

constexpr int NSLAB_MAX = 17;
__host__ __device__ constexpr int slab_count(int Ktot) { int ntk = Ktot / 64, SF = 16; if (SF > ntk / 4) SF = ntk / 4; int nkt = (ntk / SF) & ~1, rem = ntk - SF * nkt; if (rem == 2) { nkt -= 2; rem += 2 * SF; } return SF + (rem > 0 ? 1 : 0); }
__device__ __forceinline__ int resid_gemm_ctxsplit(LAS unsigned char* ring, int G, const bf16* A, long lda, const bf16* Bt, long ldb, int Ktot, const pg8::EpiResid& E, float* slab) {
    { pg8::Gemm gm{A, lda, Bt, ldb, 32, D / 256, Ktot, 0, nullptr, nullptr}; pg8::StaticOrder S; S.init(32, D / 256, G, (int)blockIdx.x); pg8::gemm_phase<pg8::EpiResid>(ring, gm, S, E); }
    const int ntk = Ktot / 64; int SF = 16; if (SF > ntk / 4) SF = ntk / 4;
    int nkt = (ntk / SF) & ~1, rem = ntk - SF * nkt; if (rem == 2) { nkt -= 2; rem += 2 * SF; }
    const bf16* Ac = A + (size_t)SEQ * lda;
    { pg8::Gemm gm{Ac, lda, Bt, ldb, 1, D / 256, nkt * 64, 0, nullptr, nullptr}; pg8::StaticOrder S; S.init(1, D / 256, G, (int)blockIdx.x, 0, D / 256, SF, 0, nkt); pg8::EpiSlab ES{slab, E.gate_ctx, 0}; pg8::gemm_phase<pg8::EpiSlab>(ring, gm, S, ES); }
    if (rem > 0) { pg8::Gemm gm{Ac, lda, Bt, ldb, 1, D / 256, rem * 64, 0, nullptr, nullptr}; pg8::StaticOrder S; S.init(1, D / 256, G, (int)((blockIdx.x + 128) % G), 0, D / 256, 1, SF * nkt, rem); pg8::EpiSlab ES{slab, E.gate_ctx, SF}; pg8::gemm_phase<pg8::EpiSlab>(ring, gm, S, ES); }
    return SF + (rem > 0 ? 1 : 0);
}

__device__ __forceinline__ void transpose_item(const float* W, long ldw, int k0, int n0, bf16* WT, long ldt, int dest_row0, LAS float* scr, int lane, bool spread = false) {
    {
        f32x4 t[8];
#pragma unroll
        for (int i = 0; i < 8; ++i) t[i] = __builtin_nontemporal_load((const f32x4*)&W[(size_t)(k0 + 8 * i + (lane >> 3)) * ldw + n0 + 4 * (lane & 7)]);
#pragma unroll
        for (int i = 0; i < 8; ++i) { LAS float* d = scr + (8 * i + (lane >> 3)) * 33 + 4 * (lane & 7); d[0] = t[i][0]; d[1] = t[i][1]; d[2] = t[i][2]; d[3] = t[i][3]; }
    }
    LDS_WAIT(); asm volatile("" ::: "memory");
    const int c = lane & 7;
#pragma unroll
    for (int j = 0; j < 4; ++j) { const int n = (lane >> 3) + 8 * j; const LAS float* s = scr + (8 * c) * 33 + n;
        u32x4 o; o.x = pk2(s[0 * 33], s[1 * 33]); o.y = pk2(s[2 * 33], s[3 * 33]); o.z = pk2(s[4 * 33], s[5 * 33]); o.w = pk2(s[6 * 33], s[7 * 33]);
        __builtin_nontemporal_store(o, (u32x4*)(WT + (size_t)(dest_row0 + (spread ? 8 * (n >> 2) + (n & 3) : n)) * ldt + k0 + 8 * c)); }
    LDS_WAIT(); asm volatile("" ::: "memory");
}
__device__ __forceinline__ void tr_plain(const float* W, int K, int N, bf16* WT, int it, LAS float* scr, int lane) {
    const int nblk = N / 32, kb = it / nblk, nb = it % nblk;
    transpose_item(W, N, 64 * kb, 32 * nb, WT, K, 32 * nb, scr, lane);
}
__device__ __forceinline__ void tr_inter(const float* W, int K, int NH, bf16* WT, int it, LAS float* scr, int lane) {
    const int nblk = 2 * NH / 32, kb = it / nblk, nb = it % nblk, n0 = 32 * nb, half = n0 / NH, j = n0 % NH;
    transpose_item(W, 2 * NH, 64 * kb, n0, WT, K, (j / 128) * 256 + half * 128 + (j % 128), scr, lane);
}

__device__ __forceinline__ void p0_prologue(Frame& F) {
    LAS float* sc = (LAS float*)(F.lds + RING_OFF);
    for (int i = F.tid; i < 2 * D; i += NWAVES * 64) { const float v = (i < D) ? F.in[1][i] : F.in[3][i - D]; sc[i] = silu_f(v); }
    __syncthreads();
    for (int it = F.gw; it < 2048; it += F.NGW) {
        const int l = it >> 9, ks = (it >> 4) & 31, rb = it & 15, r = rb * 64 + F.lane;
        const float* W = F.in[4] + ((size_t)l * D + ks * 128) * RANK + r;
        float a0 = 0.f, a1 = 0.f;
#pragma unroll 16
        for (int k = 0; k < 128; ++k) { const float w = __builtin_nontemporal_load(&W[(size_t)k * RANK]); a0 += sc[ks * 128 + k] * w; a1 += sc[D + ks * 128 + k] * w; }
        float* hp = (float*)(F.ws + WS_HIDP) + ((size_t)(l * 32 + ks) * 2) * RANK + r;
        hp[0] = a0; hp[RANK] = a1;
    }
    __syncthreads();
    for (int e = F.gw * 64 + F.lane; e < 128 * 32; e += F.NGW * 64) { float sn, cs; sincosf((float)(e >> 5) * exp2f(-(float)(e & 31) * (13.287712379549449f / 32.0f)), &sn, &cs);
        ((float*)(F.ws + WS_ROPE))[2 * e] = cs; ((float*)(F.ws + WS_ROPE))[2 * e + 1] = sn; }
}

constexpr int I_GU = 64 * (2 * DFF / 32), I_DN = (DFF / 64) * (D / 32), I_POOL = 16 * 32, I_GLU = 64 * (2 * D / 32);
constexpr int I_SQKV = 64 * (6144 / 32), I_O = 64 * (D / 32), I_NQKV = 64 * (12288 / 32);
constexpr int CV_TOTAL = 4 * I_POOL + 4 * I_GU + 4 * I_DN + I_GLU + I_SQKV + 2 * I_O + I_NQKV;
constexpr int CV_P0 = 2048  , CV_P4 = 46080  , CV_P6 = 112080  ,
              CV_P12 = 150528  , CV_P14 = 215040  , CV_P17 = 237056  ,
              CV_P22 = 303056  , CV_P25 = CV_TOTAL  ;
constexpr int BG_CONV = 16;
static_assert(CV_P4 == 4 * I_POOL + I_GU && CV_P12 == 4 * I_POOL + 2 * I_GU + 2 * I_DN + I_GLU && CV_TOTAL == 335872, "conversion list");
constexpr int CW_CONV = 1024;
__device__ __forceinline__ void conv_item(Frame& F, int idx, LAS float* scr) {
    int r = idx;
    if (r < 4 * I_POOL) { const int g = r / I_POOL; tr_plain(F.in[11] + (size_t)g * 1024 * 1024, 1024, 1024, (bf16*)(F.ws + WS_WPOOL) + (size_t)g * 1024 * 1024, r % I_POOL, scr, F.lane); return; } r -= 4 * I_POOL;
#define CV_GU(l) if (r < I_GU) { tr_inter(F.in[9] + (size_t)(l) * D * 2 * DFF, D, DFF, (bf16*)(F.ws + WS_WGU) + (size_t)(l) * 2 * DFF * D, r, scr, F.lane); return; } r -= I_GU;
#define CV_DN(l) if (r < I_DN) { tr_plain(F.in[10] + (size_t)(l) * DFF * D, DFF, D, (bf16*)(F.ws + WS_WDN) + (size_t)(l) * D * DFF, r, scr, F.lane); return; } r -= I_DN;
    CV_GU(0) CV_DN(0)
    if (r < I_GLU) { tr_inter(F.in[21], D, D, (bf16*)(F.ws + WS_WGLU), r, scr, F.lane); return; } r -= I_GLU;
    CV_GU(1) CV_DN(1)
    if (r < I_SQKV) { const int nblk = 6144 / 32, kb = r / nblk, nb = r % nblk, n0 = 32 * nb;
        if (n0 < 5120) { const int seg = (n0 & 127) >> 5; transpose_item(F.in[22], 6144, 64 * kb, n0, (bf16*)(F.ws + WS_WSQKV), D, (n0 & ~127) + 64 * (seg >> 1) + 4 * (seg & 1), scr, F.lane, true); }
        else transpose_item(F.in[22], 6144, 64 * kb, n0, (bf16*)(F.ws + WS_WSQKV), D, n0, scr, F.lane);
        return; } r -= I_SQKV;
    if (r < I_O) { tr_plain(F.in[23], D, D, (bf16*)(F.ws + WS_WSO), r, scr, F.lane); return; } r -= I_O;
    CV_GU(2) CV_DN(2)
    if (r < I_NQKV) { tr_plain(F.in[27], D, 12288, (bf16*)(F.ws + WS_WNQKV), r, scr, F.lane); return; } r -= I_NQKV;
    if (r < I_O) { tr_plain(F.in[28], D, D, (bf16*)(F.ws + WS_WNO), r, scr, F.lane); return; } r -= I_O;
    CV_GU(3) CV_DN(3)
#undef CV_GU
#undef CV_DN
}
__device__ __forceinline__ void conv_window(Frame& F, int widx, int start, int count) {
    LAS float* scr = (LAS float*)(F.lds + RING_OFF + F.wave * 16384);
    volatile LAS unsigned* MISC = (volatile LAS unsigned*)(F.lds + MISC_OFF);
    unsigned* cnt = (unsigned*)(F.ws + WS_CTL) + CW_CONV + 64 * (widx + F.cvo);
    const int nb = (count + 63) >> 6;
    for (;;) {
        __syncthreads();
        if (F.tid == 0) MISC[4] = __hip_atomic_fetch_add(cnt, 1u, __ATOMIC_RELAXED, __HIP_MEMORY_SCOPE_AGENT);
        __syncthreads();
        const int k = (int)MISC[4];
        if (k >= nb) break;
        const int i0 = start + k * 64, i1 = (i0 + 64 < start + count) ? i0 + 64 : start + count;
        for (int i = i0 + F.wave; i < i1; i += NWAVES) conv_item(F, i, scr);
    }
    __syncthreads();
}

__device__ __forceinline__ void p1_adaln2(Frame& F) {
    LAS float* hid = (LAS float*)(F.lds + RING_OFF);
    LAS float* red = (LAS float*)(F.lds + RING_OFF + 8192);
    for (int it = blockIdx.x; it < 4 * 96; it += F.G) {
        const int l = it / 96, jb = it % 96;
        __syncthreads();
        for (int i = F.tid; i < 2 * RANK; i += NWAVES * 64) { const int v = i >> 10, r = i & 1023; float s = 0.f;
#pragma unroll
            for (int ks = 0; ks < 32; ++ks) s += ((const float*)(F.ws + WS_HIDP))[((size_t)(l * 32 + ks) * 2 + v) * RANK + r];
            hid[i] = s; }
        __syncthreads();
        const float* up = F.in[5] + ((size_t)l * RANK + F.wave * 128) * (6 * D) + jb * 256 + F.lane * 4;
        f32x4 a0 = {0.f, 0.f, 0.f, 0.f}, a1 = {0.f, 0.f, 0.f, 0.f};
#pragma unroll 8
        for (int r = 0; r < 128; ++r) { const f32x4 w = __builtin_nontemporal_load((const f32x4*)(up + (size_t)r * (6 * D))); a0 += hid[F.wave * 128 + r] * w; a1 += hid[RANK + F.wave * 128 + r] * w; }
        *(LAS f32x4*)(red + (F.wave * 2 + 0) * 256 + F.lane * 4) = a0;
        *(LAS f32x4*)(red + (F.wave * 2 + 1) * 256 + F.lane * 4) = a1;
        __syncthreads();
        { const int v = F.tid >> 8, c = F.tid & 255; float s = F.in[6][(size_t)l * 6 * D + jb * 256 + c];
#pragma unroll
          for (int w = 0; w < 8; ++w) s += red[(w * 2 + v) * 256 + c];
          ((float*)(F.ws + WS_MOD))[((size_t)(l * 2 + v) * 6) * D + jb * 256 + c] = s; }
    }
}

__device__ __forceinline__ void norm_mod_phase(Frame& F, const float* xl, const float* xc, const float* gain, int l, int ish, int isc, int nrows, const float* slab = nullptr, int nslab = 0) {
    bf16* U = (bf16*)(F.ws + WS_U);
    volatile LAS unsigned* MISC = (volatile LAS unsigned*)(F.lds + MISC_OFF);
    const int b = F.vcu, n_ctx = nrows > SEQ ? (CTXL - b + F.G - 1) / F.G : 0, n_items = n_ctx + (SEQ - b + F.G - 1) / F.G;
    __syncthreads();
    if (F.tid == 0) MISC[5] = 0u;
    __syncthreads();
    for (;;) {
        int idx = 0; if (F.lane == 0) idx = (int)__hip_atomic_fetch_add((LAS unsigned*)(F.lds + MISC_OFF + 20), 1u, __ATOMIC_RELAXED, __HIP_MEMORY_SCOPE_WORKGROUP);
        idx = __builtin_amdgcn_readfirstlane(idx);
        if (idx >= n_items) break;
        const int m = idx < n_ctx ? SEQ + b + idx * F.G : b + (idx - n_ctx) * F.G;
        const bool c = m >= SEQ; const float* xr = c ? xc + (size_t)(m - SEQ) * D : xl + (size_t)m * D;
        const float* sh = modp(F, l, c ? 1 : 0, ish); const float* scl = modp(F, l, c ? 1 : 0, isc);
        f32x4 v[16]; float ss = 0.f;
#pragma unroll
        for (int j = 0; j < 16; ++j) v[j] = __builtin_nontemporal_load((const f32x4*)(xr + j * 256 + F.lane * 4));
        if (c && nslab > 0) {
            for (int sl = 0; sl < nslab; ++sl) { const float* sp = slab + ((size_t)sl * CTXL + (m - SEQ)) * D + F.lane * 4;
#pragma unroll
                for (int j = 0; j < 16; ++j) v[j] += *(const f32x4*)(sp + j * 256); }
#pragma unroll
            for (int j = 0; j < 16; ++j) *(f32x4*)((float*)xr + j * 256 + F.lane * 4) = v[j];
        }
#pragma unroll
        for (int j = 0; j < 16; ++j) { ss += (v[j][0] * v[j][0] + v[j][1] * v[j][1]) + (v[j][2] * v[j][2] + v[j][3] * v[j][3]); }
        const float rstd = rsqrtf(wave_sum(ss) * (1.0f / D) + RMS_EPS);
#pragma unroll
        for (int j = 0; j < 16; ++j) { const int e = j * 256 + F.lane * 4;
            const f32x4 g = *(const f32x4*)(gain + e), s1 = *(const f32x4*)(scl + e), s0 = *(const f32x4*)(sh + e);
            const f32x4 o = v[j] * rstd * g * (1.0f + s1) + s0;
            u32x2 w; w.x = pk2(o[0], o[1]); w.y = pk2(o[2], o[3]);
            *(u32x2*)(U + (size_t)m * D + e) = w; }
    }
}

__device__ __forceinline__ void pool_phase(Frame& F, int nrows) {
    const bf16* U = (const bf16*)(F.ws + WS_U); bf16* P = (bf16*)(F.ws + WS_P);
    const int nranges = nrows / 32;
    for (int it = F.gw; it < nranges * 8; it += F.NGW) {
        const int rg = it >> 3, slab = it & 7, m0 = rg * 32;
        const bool c = m0 >= SEQ; const int t0 = c ? m0 - SEQ : m0, L = c ? CTXL : SEQ, rb = c ? SEQ : 0;
        const int w2 = 1 << (slab >> 1), e = (slab * 64 + F.lane) * 8;
        float a[8];
#pragma unroll
        for (int q = 0; q < 8; ++q) a[q] = 0.f;
#define PL_ADD(row, sgn) do { const u32x4 x = *(const u32x4*)(U + (size_t)(rb + (row)) * D + e); \
            a[0] += (sgn) * bflo(x.x); a[1] += (sgn) * bfhi(x.x); a[2] += (sgn) * bflo(x.y); a[3] += (sgn) * bfhi(x.y); a[4] += (sgn) * bflo(x.z); a[5] += (sgn) * bfhi(x.z); a[6] += (sgn) * bflo(x.w); a[7] += (sgn) * bfhi(x.w); } while (0)
        { const int lo = (t0 - w2 > 0) ? t0 - w2 : 0, hi = (t0 + w2 < L) ? t0 + w2 : L; for (int s = lo; s < hi; ++s) PL_ADD(s, 1.0f); }
        for (int t = t0; t < t0 + 32; ++t) {
            const int lo = (t - w2 > 0) ? t - w2 : 0, hi = (t + w2 < L) ? t + w2 : L;
            const float inv = 1.0f / (float)(hi - lo);
            const u32x4 x = *(const u32x4*)(U + (size_t)(rb + t) * D + e);
            u32x4 o; o.x = pk2(a[0] * inv - bflo(x.x), a[1] * inv - bfhi(x.x)); o.y = pk2(a[2] * inv - bflo(x.y), a[3] * inv - bfhi(x.y));
            o.z = pk2(a[4] * inv - bflo(x.z), a[5] * inv - bfhi(x.z)); o.w = pk2(a[6] * inv - bflo(x.w), a[7] * inv - bfhi(x.w));
            *(u32x4*)(P + (size_t)(rb + t) * D + e) = o;
            if (t + w2 < L) PL_ADD(t + w2, 1.0f);
            if (t - w2 >= 0) PL_ADD(t - w2, -1.0f);
        }
#undef PL_ADD
    }
}

#define MFMA32(a, b, c) __builtin_amdgcn_mfma_f32_32x32x16_bf16((a), (b), (c), 0, 0, 0)
__device__ __forceinline__ int crow(int reg, int h) { return (reg & 3) + 8 * (reg >> 2) + 4 * h; }
__device__ __forceinline__ int chunk_row(int chunk, int j) { return chunk < 16 ? SEQ + chunk * 16 + j : (chunk - 16) * 16 + j; }
__device__ __forceinline__ float gelu_tanh(float x) { const float z = 0.7978845608f * (x + 0.044715f * x * x * x); return x * (1.0f - __frcp_rn(1.0f + __expf(2.0f * z))); }

__device__ __forceinline__ void s5_matgen(Frame& F, int g) {
    LAS float* zt = (LAS float*)(F.lds + RING_OFF);
    LAS float* bbt = zt + 256;
    LAS float* apw = bbt + 4096;
    LAS float* Ct = apw + 4352;
    LAS float* Kt = Ct + 4096;
    const int t = F.tid;
    __syncthreads();
    if (t < 128) {
        const int dir = t >> 6, p = t & 63; const size_t ip = ((size_t)dir * 256 + g) * 64 + p;
        const float lr = F.in[13][ip], li = F.in[14][ip], dt = expf(F.in[15][dir * 256 + g]);
        const float zr = lr * dt, zi = li * dt;
        float sn, cs; sincosf(zi, &sn, &cs);
        const float sh = sinf(0.5f * zi);
        const float em1 = expm1f(zr), mag = em1 + 1.0f;
        const float am1r = em1 * cs - 2.0f * sh * sh, ai = mag * sn;
        const float den = lr * lr + li * li;
        const float kr = (am1r * lr + ai * li) / den, ki = (ai * lr - am1r * li) / den;
        zt[(dir * 64 + p) * 2 + 0] = zr; zt[(dir * 64 + p) * 2 + 1] = zi;
#pragma unroll
        for (int h = 0; h < 16; ++h) { const float br = F.in[16][ip * 16 + h], bi = F.in[17][ip * 16 + h];
            bbt[((dir * 64 + p) * 16 + h) * 2 + 0] = kr * br - ki * bi; bbt[((dir * 64 + p) * 16 + h) * 2 + 1] = kr * bi + ki * br; }
    }
    for (int e = t; e < 2048; e += NWAVES * 64) { const int dir = e >> 10, h = (e >> 6) & 15, p = e & 63; const size_t ic = (((size_t)dir * 256 + g) * 16 + h) * 64 + p;
        Ct[e * 2 + 0] = F.in[18][ic]; Ct[e * 2 + 1] = F.in[19][ic]; }
    __syncthreads();
    for (int e = t; e < 2176; e += NWAVES * 64) { const int dir = e / 1088, rem = e % 1088, d = rem >> 6, p = rem & 63;
        const float zr = zt[(dir * 64 + p) * 2], zi = zt[(dir * 64 + p) * 2 + 1];
        const float mag = expf((float)d * zr); float sn, cs; sincosf((float)d * zi, &sn, &cs);
        apw[e * 2 + 0] = mag * cs; apw[e * 2 + 1] = mag * sn; }
    __syncthreads();
    for (int cbo = 0; cbo < 4; ++cbo) {
        const int dd = F.wave * 4 + cbo, dir = dd >> 4, d = dd & 15, lr16 = F.lane & 15, lq = F.lane >> 4;
        f32x4 kacc = {0.f, 0.f, 0.f, 0.f};
#pragma unroll 4
        for (int p0 = 0; p0 < 64; p0 += 4) { const int p = p0 + lq;
            const float ar = apw[((dir * 17 + d) * 64 + p) * 2], ai = apw[((dir * 17 + d) * 64 + p) * 2 + 1];
            const float br = bbt[((dir * 64 + p) * 16 + lr16) * 2], bi = bbt[((dir * 64 + p) * 16 + lr16) * 2 + 1];
            const float wr = ar * br - ai * bi, wi = ar * bi + ai * br;
            const float cr = Ct[((dir * 16 + lr16) * 64 + p) * 2], ci = Ct[((dir * 16 + lr16) * 64 + p) * 2 + 1];
            kacc = __builtin_amdgcn_mfma_f32_16x16x4f32(cr, wr, kacc, 0, 0, 0);
            kacc = __builtin_amdgcn_mfma_f32_16x16x4f32(-ci, wi, kacc, 0, 0, 0); }
#pragma unroll
        for (int i = 0; i < 4; ++i) Kt[(dir * 16 + d) * 256 + (4 * lq + i) * 16 + lr16] = kacc[i];
    }
    __syncthreads();
    bf16* MF = (bf16*)(F.ws + WS_MF) + (size_t)g * 256 * 512; bf16* EG = (bf16*)(F.ws + WS_EG) + (size_t)g * 256 * 256;
    for (int e = t; e < 256 * 64; e += NWAVES * 64) {
        const int n = e >> 6, k0 = (e & 63) * 8, i = n >> 4, h = n & 15; float v[8];
        if (k0 < 256) { const int j = k0 >> 4, hp0 = k0 & 15;
#pragma unroll
            for (int q = 0; q < 8; ++q) { float x = 0.f; if (j <= i) x += Kt[(0 * 16 + (i - j)) * 256 + h * 16 + hp0 + q]; if (j >= i) x += Kt[(1 * 16 + (j - i)) * 256 + h * 16 + hp0 + q]; v[q] = x; }
        } else { const int q0 = k0 - 256, seg = q0 >> 6, dir = seg >> 1, pw = dir == 0 ? i + 1 : 16 - i;
#pragma unroll
            for (int q = 0; q < 8; ++q) { const int p = (q0 & 63) + q; const float ar = apw[((dir * 17 + pw) * 64 + p) * 2], ai = apw[((dir * 17 + pw) * 64 + p) * 2 + 1];
                const float cr = Ct[((dir * 16 + h) * 64 + p) * 2], ci = Ct[((dir * 16 + h) * 64 + p) * 2 + 1];
                v[q] = (seg & 1) ? -(cr * ai + ci * ar) : (cr * ar - ci * ai); }
        }
        u32x4 o; o.x = pk2(v[0], v[1]); o.y = pk2(v[2], v[3]); o.z = pk2(v[4], v[5]); o.w = pk2(v[6], v[7]);
        *(u32x4*)(MF + ((size_t)(((k0 >> 4) * 8 + (n >> 5)) * 64 + ((k0 >> 3) & 1) * 32 + (n & 31))) * 8) = o;
    }
    for (int e = t; e < 256 * 32; e += NWAVES * 64) {
        const int n = e >> 5, k0 = (e & 31) * 8, seg = n >> 6, p = n & 63, dir = seg >> 1, j = k0 >> 4, hp0 = k0 & 15, pw = dir == 0 ? 15 - j : j; float v[8];
        const float ar = apw[((dir * 17 + pw) * 64 + p) * 2], ai = apw[((dir * 17 + pw) * 64 + p) * 2 + 1];
#pragma unroll
        for (int q = 0; q < 8; ++q) { const float br = bbt[((dir * 64 + p) * 16 + hp0 + q) * 2], bi = bbt[((dir * 64 + p) * 16 + hp0 + q) * 2 + 1];
            v[q] = (seg & 1) ? (ar * bi + ai * br) : (ar * br - ai * bi); }
        u32x4 o; o.x = pk2(v[0], v[1]); o.y = pk2(v[2], v[3]); o.z = pk2(v[4], v[5]); o.w = pk2(v[6], v[7]);
        *(u32x4*)(EG + ((size_t)(((k0 >> 4) * 8 + (n >> 5)) * 64 + ((k0 >> 3) & 1) * 32 + (n & 31))) * 8) = o;
    }
    __syncthreads();
}

#define S5_STAGE(src_expr, w0, nw) do { for (int _q = F.wave - (w0); _q < 128; _q += (nw)) { const int q = _q; \
        __builtin_amdgcn_global_load_lds((const unsigned*)((src_expr) + F.lane * 8), (LAS unsigned*)(F.lds + RING_OFF + q * 1024), 16, 0, 2); } } while (0)
__device__ __forceinline__ void s5_phase(Frame& F) {
    const bf16* U = (const bf16*)(F.ws + WS_U); bf16* Gb = (bf16*)(F.ws + WS_P); const int r = F.lane & 31, h = F.lane >> 5;
    const LAS unsigned char* img = F.lds + RING_OFF;
    for (int g = F.vcu; g < 256; g += F.G) {
        const bf16* EG = (const bf16*)(F.ws + WS_EG) + (size_t)g * 256 * 256;
        const bf16* MF = (const bf16*)(F.ws + WS_MF) + (size_t)g * 256 * 512;
        float* HL = (float*)(F.ws + WS_HLOC) + (size_t)g * 528 * 256;
        bf16* HCg = (bf16*)(F.ws + WS_HC) + (size_t)g * 17 * 16 * 512;
        S5_STAGE(EG + (size_t)q * 512, 0, NWAVES);
        asm volatile("s_waitcnt vmcnt(0)" ::: "memory"); __syncthreads();
        for (int cb = F.wave; cb < 16; cb += NWAVES) {
            const int chunk = cb * 32 + r;
            f32x16 acc[8];
#pragma unroll
            for (int nb = 0; nb < 8; ++nb)
#pragma unroll
                for (int i = 0; i < 16; ++i) acc[nb][i] = 0.f;
#pragma unroll 1
            for (int k0 = 0; k0 < 16; k0 += 4) {
                bf16x8 a[4];
#pragma unroll
                for (int q = 0; q < 4; ++q) a[q] = *(const bf16x8*)(U + (size_t)chunk_row(chunk, k0 + q) * D + g * 16 + 8 * h);
#pragma unroll
                for (int q = 0; q < 4; ++q)
#pragma unroll
                    for (int nh4 = 0; nh4 < 2; ++nh4) { bf16x8 b[4];
                        __builtin_amdgcn_sched_barrier(0);
#pragma unroll
                        for (int nb = 0; nb < 4; ++nb) b[nb] = *(const LAS bf16x8*)(img + (((k0 + q) * 8 + nh4 * 4 + nb) * 64 + F.lane) * 16);
                        __builtin_amdgcn_sched_barrier(0);
#pragma unroll
                        for (int nb = 0; nb < 4; ++nb) acc[nh4 * 4 + nb] = MFMA32(a[q], b[nb], acc[nh4 * 4 + nb]); }
            }
#pragma unroll
            for (int nb = 0; nb < 8; ++nb)
#pragma unroll
                for (int i = 0; i < 16; ++i) HL[(size_t)(cb * 32 + crow(i, h)) * 256 + nb * 32 + r] = acc[nb][i];
        }
        {
            int chunk = 512 + r; if (chunk > 527) chunk = 527;
            f32x16 acc1;
#pragma unroll
            for (int i = 0; i < 16; ++i) acc1[i] = 0.f;
#pragma unroll 1
            for (int k0 = 0; k0 < 16; k0 += 8) { bf16x8 a[8];
#pragma unroll
                for (int q = 0; q < 8; ++q) a[q] = *(const bf16x8*)(U + (size_t)chunk_row(chunk, k0 + q) * D + g * 16 + 8 * h);
#pragma unroll
                for (int q = 0; q < 8; ++q) acc1 = MFMA32(a[q], *(const LAS bf16x8*)(img + (((k0 + q) * 8 + F.wave) * 64 + F.lane) * 16), acc1); }
#pragma unroll
            for (int i = 0; i < 16; ++i) { const int ch = 512 + crow(i, h); if (ch < 528) HL[(size_t)ch * 256 + F.wave * 32 + r] = acc1[i]; }
        }
        asm volatile("s_waitcnt vmcnt(0)" ::: "memory"); __syncthreads();
        S5_STAGE(MF + (size_t)(((q >> 2) * 8 + (q & 3)) * 512), 0, NWAVES);
        {
            const int dir = F.wave & 1, seg = F.wave >> 1, p = F.lane; const size_t ip = ((size_t)dir * 256 + g) * 64 + p;
            const float lr = F.in[13][ip], li = F.in[14][ip], dt = expf(F.in[15][dir * 256 + g]);
            const float mag = expf(16.0f * lr * dt); float sn, cs; sincosf(16.0f * li * dt, &sn, &cs);
            const float ar = mag * cs, ai = mag * sn;
            float qr = ar, qi = ai, a4r = 0.f, a4i = 0.f;
#pragma unroll
            for (int e = 1; e <= 7; ++e) { const float tr = qr * qr - qi * qi, ti = 2.0f * qr * qi; qr = tr; qi = ti; if (e == 2) { a4r = qr; a4i = qi; } }
            const float Ar = qr * a4r - qi * a4i, Ai = qr * a4i + qi * a4r;
            const float* HLp = HL + dir * 128 + p;
            const int nre = dir * 128 + p, nim = nre + 64;
            const int ore = ((nre >> 4) * 64 + ((nre >> 3) & 1) * 32) * 8 + (nre & 7), oim = ((nim >> 4) * 64 + ((nim >> 3) & 1) * 32) * 8 + (nim & 7);
            LAS float* ex = (LAS float*)(F.lds + MISC_OFF + 4096);
            float hr = 0.f, hi = 0.f;
            for (int s0 = 132 * seg; s0 < 132 * seg + 132; s0 += 22) {
                float xr[22], xi[22];
#pragma unroll
                for (int q = 0; q < 22; ++q) { const int s = s0 + q, c = dir == 0 ? s : (s < 16 ? 15 - s : 543 - s); xr[q] = HLp[(size_t)c * 256]; xi[q] = HLp[(size_t)c * 256 + 64]; }
#pragma unroll
                for (int q = 0; q < 22; ++q) { const float nr = ar * hr - ai * hi + xr[q], ni = ar * hi + ai * hr + xi[q]; hr = nr; hi = ni; }
            }
            ex[((dir * 4 + seg) * 64 + p) * 2] = hr; ex[((dir * 4 + seg) * 64 + p) * 2 + 1] = hi;
            asm volatile("s_waitcnt lgkmcnt(0)" ::: "memory"); __builtin_amdgcn_s_barrier(); asm volatile("" ::: "memory");
            hr = 0.f; hi = 0.f;
            for (int q = 0; q < seg; ++q) { const float er = ex[((dir * 4 + q) * 64 + p) * 2], ei = ex[((dir * 4 + q) * 64 + p) * 2 + 1];
                const float nr = Ar * hr - Ai * hi + er, ni = Ar * hi + Ai * hr + ei; hr = nr; hi = ni; }
            for (int s0 = 132 * seg; s0 < 132 * seg + 132; s0 += 22) {
                float xr[22], xi[22];
#pragma unroll
                for (int q = 0; q < 22; ++q) { const int s = s0 + q, c = dir == 0 ? s : (s < 16 ? 15 - s : 543 - s); xr[q] = HLp[(size_t)c * 256]; xi[q] = HLp[(size_t)c * 256 + 64]; }
#pragma unroll
                for (int q = 0; q < 22; ++q) {
                    const int s = s0 + q, c = dir == 0 ? s : (s < 16 ? 15 - s : 543 - s);
                    { const size_t cbo = (size_t)(c >> 5) * 16 * 512 + (c & 31) * 8; HCg[cbo + ore] = (bf16)(pk2(hr, 0.f) & 0xffffu); HCg[cbo + oim] = (bf16)(pk2(hi, 0.f) & 0xffffu); }
                    const float nr = ar * hr - ai * hi + xr[q], ni = ar * hi + ai * hr + xi[q]; hr = nr; hi = ni; }
            }
        }
        asm volatile("s_waitcnt vmcnt(0)" ::: "memory"); __syncthreads();
        for (int nh = 0; nh < 2; ++nh) {
            if (nh == 1) { __syncthreads(); S5_STAGE(MF + (size_t)(((q >> 2) * 8 + 4 + (q & 3)) * 512), 0, NWAVES); asm volatile("s_waitcnt vmcnt(0)" ::: "memory"); __syncthreads(); }
            const int hh = r & 15; const float dv = F.in[20][g * 16 + hh];
            for (int cb = F.wave; cb < 16; cb += NWAVES) {
                const int chunk = cb * 32 + r;
                const bf16* HC = HCg + (size_t)cb * 16 * 512 + F.lane * 8;
                f32x16 acc[4];
#pragma unroll
                for (int nb = 0; nb < 4; ++nb)
#pragma unroll
                    for (int i = 0; i < 16; ++i) acc[nb][i] = 0.f;
#pragma unroll
                for (int part = 0; part < 2; ++part) {
                    bf16x8 a[16];
#pragma unroll
                    for (int q = 0; q < 16; ++q) a[q] = part == 0 ? *(const bf16x8*)(U + (size_t)chunk_row(chunk, q) * D + g * 16 + 8 * h) : *(const bf16x8*)(HC + (size_t)q * 512);
#pragma unroll
                    for (int q = 0; q < 16; ++q) { bf16x8 b[4];
                        __builtin_amdgcn_sched_barrier(0);
#pragma unroll
                        for (int nb = 0; nb < 4; ++nb) b[nb] = *(const LAS bf16x8*)(img + (((part * 16 + q) * 4 + nb) * 64 + F.lane) * 16);
                        __builtin_amdgcn_sched_barrier(0);
#pragma unroll
                        for (int nb = 0; nb < 4; ++nb) acc[nb] = MFMA32(a[q], b[nb], acc[nb]); }
                }
#pragma unroll
                for (int nb = 0; nb < 4; ++nb)
#pragma unroll
                    for (int i = 0; i < 16; ++i) { const int ch = cb * 32 + crow(i, h); const int tok = (nh * 4 + nb) * 2 + (r >> 4); const size_t o = (size_t)chunk_row(ch, tok) * D + g * 16 + hh;
                        const float u = bf2f(U[o]); Gb[o] = (bf16)(pk2(gelu_tanh(acc[nb][i] + dv * u), 0.f) & 0xffffu); }
            }
            if ((F.wave >> 2) == nh) {
                const int nb = F.wave & 3; int chunk = 512 + r; if (chunk > 527) chunk = 527;
                const bf16* HC = HCg + (size_t)16 * 16 * 512 + F.lane * 8;
                f32x16 acc1;
#pragma unroll
                for (int i = 0; i < 16; ++i) acc1[i] = 0.f;
#pragma unroll 1
                for (int k0 = 0; k0 < 32; k0 += 8) { bf16x8 a[8];
#pragma unroll
                    for (int q = 0; q < 8; ++q) a[q] = k0 < 16 ? *(const bf16x8*)(U + (size_t)chunk_row(chunk, k0 + q) * D + g * 16 + 8 * h) : *(const bf16x8*)(HC + (size_t)(k0 - 16 + q) * 512);
#pragma unroll
                    for (int q = 0; q < 8; ++q) acc1 = MFMA32(a[q], *(const LAS bf16x8*)(img + (((k0 + q) * 4 + nb) * 64 + F.lane) * 16), acc1); }
#pragma unroll
                for (int i = 0; i < 16; ++i) { const int ch = 512 + crow(i, h);
                    if (ch < 528) { const int tok = (nh * 4 + nb) * 2 + (r >> 4); const size_t o = (size_t)chunk_row(ch, tok) * D + g * 16 + hh;
                        const float u = bf2f(U[o]); Gb[o] = (bf16)(pk2(gelu_tanh(acc1[i] + dv * u), 0.f) & 0xffffu); } }
            }
        }
        asm volatile("s_waitcnt vmcnt(0)" ::: "memory"); __syncthreads();
    }
}
#undef S5_STAGE


template <bool ROPE>
__device__ __forceinline__ void headnorm_phase(Frame& F, bf16* QK, long ld, int nq, int nk, const float* qg, const float* kg, int nrows) {
    const int i = F.lane & 31, hb = F.lane >> 5;
    const float inv = exp2f(-(float)i * (13.287712379549449f / 32.0f));
    float gq[4], gk[4];
#pragma unroll
    for (int s = 0; s < 4; ++s) { gq[s] = qg[32 * s + i] * QSCALE; gk[s] = kg[32 * s + i]; }
    for (int m = F.gw; m < nrows; m += F.NGW) {
        float cr = 1.f, sr = 0.f, cc = 1.f, sc = 0.f;
        if (ROPE && m < SEQ) { sincosf((float)(m >> 6) * inv, &sr, &cr); sincosf((float)(m & 63) * inv, &sc, &cc); }
        bf16* rowp = QK + (size_t)m * ld;
        for (int hp = 0; hp < nq + nk; hp += 2) {
            const int head = hp + hb; bf16* p = rowp + head * 128 + i;
            const float x0 = bf2f(p[0]), x1 = bf2f(p[32]), x2 = bf2f(p[64]), x3 = bf2f(p[96]);
            float ss = (x0 * x0 + x1 * x1) + (x2 * x2 + x3 * x3);
#pragma unroll
            for (int o = 1; o < 32; o <<= 1) ss += __shfl_xor(ss, o);
            const float rs = rsqrtf(ss * (1.0f / 128.0f) + RMS_EPS);
            const bool isq = head < nq;
            const float y0 = x0 * rs * (isq ? gq[0] : gk[0]), y1 = x1 * rs * (isq ? gq[1] : gk[1]), y2 = x2 * rs * (isq ? gq[2] : gk[2]), y3 = x3 * rs * (isq ? gq[3] : gk[3]);
            const float o0 = y0 * cr - y1 * sr, o1 = y1 * cr + y0 * sr, o2 = y2 * cc - y3 * sc, o3 = y3 * cc + y2 * sc;
            p[0] = (bf16)(pk2(o0, 0.f) & 0xffffu); p[32] = (bf16)(pk2(o1, 0.f) & 0xffffu); p[64] = (bf16)(pk2(o2, 0.f) & 0xffffu); p[96] = (bf16)(pk2(o3, 0.f) & 0xffffu);
        }
    }
}

#define ATT_SOFTMAX(sv, pv, sidx) do { \
        if (MODE == 1 && usebias) { _Pragma("unroll") for (int i = 0; i < 16; ++i) pv[i] = __builtin_amdgcn_exp2f(sv[i] + tabp[32 * (sidx) + 16 * (i >> 3) + (i & 7)]); } \
        else { _Pragma("unroll") for (int i = 0; i < 16; ++i) pv[i] = __builtin_amdgcn_exp2f(sv[i]); } \
        if (mk[sidx]) { _Pragma("unroll") for (int i = 0; i < 16; ++i) { const int ci = 16 * (i >> 3) + (i & 7); \
            const bool valid = (MODE == 1) ? (((vbits >> (16 * (sidx) + i)) & 1u) != 0u) : (ci >= L[sidx] && ci <= H[sidx]); pv[i] = valid ? pv[i] : 0.f; } } \
        _Pragma("unroll") for (int i = 0; i < 16; ++i) lsum += pv[i]; } while (0)
#define ATT_PACK(pv, xsv) do { _Pragma("unroll") for (int st = 0; st < 2; ++st) { u32x4 xw; xw.x = pk2(pv[8 * st], pv[8 * st + 1]); xw.y = pk2(pv[8 * st + 2], pv[8 * st + 3]); \
        xw.z = pk2(pv[8 * st + 4], pv[8 * st + 5]); xw.w = pk2(pv[8 * st + 6], pv[8 * st + 7]); xsv[st] = __builtin_bit_cast(bf16x8, xw); } } while (0)
template <int MODE>
__device__ __forceinline__ void attn_tile2(const LAS unsigned char* Kt, const LAS unsigned char* Vt, const bf16x8 (&qf)[8], f32x16 (&o)[4], float& lsum, float M2, int r, int h, int pr,
                                           const bool (&mk)[2], const int (&L)[2], const int (&H)[2], unsigned vbits, bool usebias, const LAS float* tabp) {
    f32x16 s0, s1;
#pragma unroll
    for (int i = 0; i < 16; ++i) { s0[i] = -M2; s1[i] = -M2; }
    const int rowk0 = pr, rowk1 = 32 + pr, kx = pr & 15;
    bf16x8 fr[8];
    __builtin_amdgcn_sched_barrier(0);
#pragma unroll
    for (int ks = 0; ks < 8; ++ks) fr[ks] = *(const LAS bf16x8*)(Kt + rowk0 * 256 + (((2 * ks + h) ^ kx) << 4));
    __builtin_amdgcn_sched_barrier(0);
#pragma unroll
    for (int ks = 0; ks < 8; ++ks) s0 = MFMA32(fr[ks], qf[ks], s0);
    __builtin_amdgcn_sched_barrier(0);
#pragma unroll
    for (int ks = 0; ks < 8; ++ks) fr[ks] = *(const LAS bf16x8*)(Kt + rowk1 * 256 + (((2 * ks + h) ^ kx) << 4));
    __builtin_amdgcn_sched_barrier(0);
    float p0[16], p1[16]; bf16x8 xs0[2], xs1[2];
#pragma unroll
    for (int ks = 0; ks < 8; ++ks) s1 = MFMA32(fr[ks], qf[ks], s1);
    ATT_SOFTMAX(s0, p0, 0);
    ATT_PACK(p0, xs0);
    __builtin_amdgcn_sched_barrier(0);
#pragma unroll
    for (int st = 0; st < 2; ++st)
#pragma unroll
        for (int db = 0; db < 4; ++db) { const int rowv = db * 32 + r, vx = (rowv >> 1) & 7; fr[st * 4 + db] = *(const LAS bf16x8*)(Vt + rowv * 128 + (((2 * st + h) ^ vx) << 4)); }
    __builtin_amdgcn_sched_barrier(0);
#pragma unroll
    for (int st = 0; st < 2; ++st)
#pragma unroll
        for (int db = 0; db < 4; ++db) o[db] = MFMA32(fr[st * 4 + db], xs0[st], o[db]);
    ATT_SOFTMAX(s1, p1, 1);
    ATT_PACK(p1, xs1);
    __builtin_amdgcn_sched_barrier(0);
#pragma unroll
    for (int st = 0; st < 2; ++st)
#pragma unroll
        for (int db = 0; db < 4; ++db) { const int rowv = db * 32 + r, vx = (rowv >> 1) & 7; fr[st * 4 + db] = *(const LAS bf16x8*)(Vt + rowv * 128 + (((4 + 2 * st + h) ^ vx) << 4)); }
    __builtin_amdgcn_sched_barrier(0);
#pragma unroll
    for (int st = 0; st < 2; ++st)
#pragma unroll
        for (int db = 0; db < 4; ++db) o[db] = MFMA32(fr[st * 4 + db], xs1[st], o[db]);
    __builtin_amdgcn_sched_barrier(0);
}
#undef ATT_SOFTMAX
#undef ATT_PACK

template <int MODE>
__device__ __forceinline__ void attn_phase(Frame& F, const bf16* QK, long ldqk, int koff, const bf16* VT, long ldv, const float* qg, const float* kg, const float* extra, bool ctx_out) {
    bf16* O = (bf16*)(F.ws + WS_P); const int r = F.lane & 31, h = F.lane >> 5, pr = (r & ~12) | ((r & 4) << 1) | ((r & 8) >> 1);
    LAS unsigned char* KB = F.lds + RING_OFF;
    LAS float* tab = (LAS float*)(F.lds + MISC_OFF + 256);
    float mq = fmaxf(fabsf(qg[F.lane]), fabsf(qg[64 + F.lane])), mk = fmaxf(fabsf(kg[F.lane]), fabsf(kg[64 + F.lane]));
#pragma unroll
    for (int o = 1; o < 64; o <<= 1) { mq = fmaxf(mq, __shfl_xor(mq, o)); mk = fmaxf(mk, __shfl_xor(mk, o)); }
    const float M2 = 11.313708498984761f * mq * mk * LOG2E;
    const int n_lat = 1024, n_items = n_lat + (ctx_out ? (MODE == 0 ? 32 : 128) : 0);
    const int w = F.wave;
    for (int it = F.vcu; it < n_items; it += F.G) {
        int hq, hkv, q0, lbase = 0, nl = 0, rw = 0, qh = 0, r0w = 0, krlo = 0;
        if (it < n_lat) {
            if (MODE == 0) { hkv = it >> 7; const int qb = it & 127; hq = hkv * 4 + (w & 3); q0 = qb * 64 + 32 * (w >> 2);
                lbase = qb * 64 - 128; if (lbase < 0) lbase = 0; int lend = qb * 64 + 192; if (lend > SEQ) lend = SEQ; nl = (lend - lbase) >> 6; }
            else { hkv = hq = it >> 5; const int R0 = 4 * (it & 31); rw = R0 + (w >> 1); qh = w & 1; q0 = rw * 64 + 32 * qh;
                r0w = rw - 4; r0w = r0w < 0 ? 0 : (r0w > 120 ? 120 : r0w);
                krlo = R0 - 4; krlo = krlo < 0 ? 0 : (krlo > 120 ? 120 : krlo); int khi = R0 - 1; khi = khi < 0 ? 0 : (khi > 120 ? 120 : khi); khi += 7;
                lbase = krlo * 64; nl = khi - krlo + 1; }
        } else {
            const int j = it - n_lat;
            if (MODE == 0) { hkv = j >> 2; hq = hkv * 4 + (w & 3); q0 = SEQ + (j & 3) * 64 + 32 * (w >> 2); }
            else { hkv = hq = j >> 2; q0 = SEQ + (j & 3) * 64 + 32 * (w & 1); }
        }
        const int nt = nl + 4;
        const int cq = qh * 32 + r; int c0 = cq - 8; c0 = c0 < 0 ? 0 : (c0 > 48 ? 48 : c0);
        unsigned vbits = 0u;
        if (MODE == 1) {
#pragma unroll
            for (int e = 0; e < 32; ++e) { const int kc = 32 * (e >> 4) + 16 * ((e & 15) >> 3) + 8 * h + (e & 7); if (kc >= c0 && kc < c0 + 16) vbits |= 1u << e; } }
        float Mi = M2;
        if (MODE == 1) {
            float bm = 0.f;
            if (w == 0) { for (int e = F.lane; e < 465; e += 64) tab[e] = extra[hq * 465 + e] * LOG2E; LDS_WAIT(); }
            for (int e = F.lane; e < 465; e += 64) bm = fmaxf(bm, fabsf(extra[hq * 465 + e]));
#pragma unroll
            for (int o = 1; o < 64; o <<= 1) bm = fmaxf(bm, __shfl_xor(bm, o));
            Mi += bm * LOG2E;
        }
        bf16x8 qf[8];
#pragma unroll
        for (int ks = 0; ks < 8; ++ks) qf[ks] = *(const bf16x8*)(QK + (size_t)(q0 + r) * ldqk + hq * 128 + 16 * ks + 8 * h);
        f32x16 o[4];
#pragma unroll
        for (int db = 0; db < 4; ++db)
#pragma unroll
            for (int i = 0; i < 16; ++i) o[db][i] = 0.f;
        float lsum = 0.f;
        const bf16* kbase = QK + koff + hkv * 128; const bf16* vbase = VT + (size_t)hkv * 128 * ldv;
#define ATT_KEY0(j) ((j) < nl ? lbase + 64 * (j) : SEQ + 64 * ((j) - nl))
#define ATT_GLDS(j, b) do { const int _k0 = ATT_KEY0(j); _Pragma("unroll") for (int _i = 0; _i < 2; ++_i) { const int _q = w + 8 * _i; \
            { const int _row = _q * 4 + (F.lane >> 4), _ch = (F.lane & 15) ^ (_row & 15); \
              __builtin_amdgcn_global_load_lds((const unsigned*)(kbase + (size_t)(_k0 + _row) * ldqk + _ch * 8), (LAS unsigned*)(KB + (b) * 32768 + _q * 1024), 16, 0, 0); } \
            { const int _row = _q * 8 + (F.lane >> 3), _ch = (F.lane & 7) ^ ((_row >> 1) & 7); \
              __builtin_amdgcn_global_load_lds((const unsigned*)(vbase + (size_t)_row * ldv + _k0 + _ch * 8), (LAS unsigned*)(KB + (b) * 32768 + 16384 + _q * 1024), 16, 0, 0); } } } while (0)
        ATT_GLDS(0, 0); if (nt > 1) ATT_GLDS(1, 1);
        asm volatile("" : "+v"(qf[0]), "+v"(qf[1]), "+v"(qf[2]), "+v"(qf[3]), "+v"(qf[4]), "+v"(qf[5]), "+v"(qf[6]), "+v"(qf[7]));
        int bcur = 0;
        for (int j = 0; j < nt; ++j) {
            if (j + 1 < nt) asm volatile("s_waitcnt vmcnt(4)" ::: "memory"); else asm volatile("s_waitcnt vmcnt(0)" ::: "memory");
            asm volatile("s_waitcnt lgkmcnt(0)" ::: "memory"); __builtin_amdgcn_s_barrier(); asm volatile("" ::: "memory");
            if (j + 2 < nt) { const int b2 = bcur >= 1 ? bcur - 1 : 2; ATT_GLDS(j + 2, b2); }
            const LAS unsigned char* Kt = KB + bcur * 32768; const LAS unsigned char* Vt = Kt + 16384;
            {
                bool rel = true, ub = false; bool mk[2] = {false, false}; int L[2] = {0, 0}, H[2] = {0, 0}; const LAS float* tabp = tab;
                if (j < nl) {
                    if (MODE == 0) { bool any = false;
#pragma unroll
                        for (int sub = 0; sub < 2; ++sub) { const int dd = lbase + 64 * j + 32 * sub - (q0 - 128); const bool rl = dd >= 0 && dd <= 256; any = any || rl;
                            mk[sub] = (dd == 0) || (dd == 256) || !rl; L[sub] = !rl ? 1000 : ((dd == 0) ? r - 8 * h : -1000); H[sub] = !rl ? -1000 : ((dd == 256) ? r - 8 * h : 1000); }
                        rel = any; }
                    else { const int kr = krlo + j; rel = kr >= r0w && kr <= r0w + 7; mk[0] = mk[1] = true; ub = true; tabp = tab + ((kr - rw + 7) * 31 + 8 * h - cq + 15); }
                }
                if (rel) attn_tile2<MODE>(Kt, Vt, qf, o, lsum, Mi, r, h, pr, mk, L, H, vbits, ub, tabp);
            }
            bcur = bcur == 2 ? 0 : bcur + 1;
        }
#undef ATT_KEY0
#undef ATT_GLDS
        float l = lsum + __shfl_xor(lsum, 32);
        if (MODE == 0) l += __builtin_amdgcn_exp2f(extra[hq] * LOG2E - Mi);
        const float il = 1.0f / l;
        bf16* orow = O + (size_t)(q0 + r) * D + hq * 128;
#pragma unroll
        for (int db = 0; db < 4; ++db)
#pragma unroll
            for (int gq4 = 0; gq4 < 4; ++gq4) { u32x2 wv; wv.x = pk2(o[db][4 * gq4] * il, o[db][4 * gq4 + 1] * il); wv.y = pk2(o[db][4 * gq4 + 2] * il, o[db][4 * gq4 + 3] * il);
                *(u32x2*)(orow + db * 32 + 8 * gq4 + 4 * h) = wv; }
        asm volatile("s_waitcnt vmcnt(0) lgkmcnt(0)" ::: "memory"); __builtin_amdgcn_s_barrier(); asm volatile("" ::: "memory");
    }
}

__global__ void __launch_bounds__(NWAVES * 64, 2) mk_fwd(Args args) {
    extern __shared__ __attribute__((aligned(16))) unsigned char lds[];
    Frame F;
    F.lds = (LAS unsigned char*)lds;
    F.tid = threadIdx.x; F.lane = F.tid & 63; F.wave = __builtin_amdgcn_readfirstlane(F.tid >> 6);
    F.G = gridDim.x; { const int bx = blockIdx.x; F.vcu = (F.G % 8 == 0) ? (bx % 8) * (F.G / 8) + bx / 8 : bx; }
    F.gw = F.vcu * NWAVES + F.wave; F.NGW = F.G * NWAVES;
#pragma unroll
    for (int i = 0; i < 32; ++i) F.in[i] = args.in[i];
    F.out = args.out; F.ws = args.ws; F.cvo = args.cvo;
    volatile LAS unsigned* MISC = (volatile LAS unsigned*)(F.lds + MISC_OFF);
    if (F.tid < 16) MISC[F.tid] = 0u;
    __syncthreads();
    unsigned* barw = (unsigned*)(F.ws + WS_CTL) + CW_BAR + args.li * XCD_BAR_WORDS;
    XcdBarrier bar; bar.bar = barw; bar.x = 0; bar.st = nullptr;
    if (!MK_PER_PHASE) bar = xcd_barrier_post(barw, MISC + 8);
#define GRID_BAR() do { if (!MK_PER_PHASE) xcd_barrier(bar); } while (0)
    const int lo = args.ph_lo, hi = args.ph_hi;
#define IN(k) (lo <= (k) && (k) < hi)
#define BOTH(k) (IN(k) && IN((k) + 1))
    LAS unsigned char* ring = F.lds + RING_OFF;
    float* X = (float*)(F.ws + WS_X);
    bf16* U = (bf16*)(F.ws + WS_U); bf16* P = (bf16*)(F.ws + WS_P); bf16* H = (bf16*)(F.ws + WS_H);

    if (IN(0)) { p0_prologue(F); for (int g = blockIdx.x; g < 256; g += F.G) s5_matgen(F, g); conv_window(F, 0, 0, CV_P0); if (BOTH(0)) GRID_BAR(); }
    if (IN(1)) { p1_adaln2(F); if (BOTH(1)) GRID_BAR(); }
    float* XC = X + (size_t)SEQ * D; float* SLAB = (float*)(F.ws + WS_SLAB);

#define FFN_PHASES(pb, l, nM_, nrows_, outl_, CVA, CVB, NS, BG)                                                                                      \
    if (IN(pb)) { norm_mod_phase(F, X, XC, F.in[8] + (l) * D, (l), 3, 4, (nrows_), SLAB, (NS)); if (BOTH(pb)) GRID_BAR(); }             \
    if (IN((pb) + 1)) {                                                                                                              \
        pg8::Gemm gm{U, D, (const bf16*)(F.ws + WS_WGU) + (size_t)(l) * 2 * DFF * D, D, (nM_), 2 * DFF / 256, D, 0, nullptr, nullptr};                  \
        const int GC = F.G - (BG);             \
        pg8::StaticOrder S; S.init((nM_), 2 * DFF / 256, GC, (int)blockIdx.x);                                                       \
        pg8::EpiSwiGLU E{H, DFF};                                                                                                    \
        if ((int)blockIdx.x < GC) pg8::gemm_phase<pg8::EpiSwiGLU>(ring, gm, S, E);                                                   \
        CVA;                                                                                                                         \
        if (BOTH((pb) + 1)) GRID_BAR();                                                                                              \
    }                                                                                                                                \
    if (IN((pb) + 2)) {                                                                                                              \
        pg8::EpiResid E{X, XC, (outl_), XC, modp(F, (l), 0, 5), modp(F, (l), 1, 5), nullptr, 0};                                \
        if ((nM_) == 33) (void)resid_gemm_ctxsplit(ring, F.G, H, DFF, (const bf16*)(F.ws + WS_WDN) + (size_t)(l) * D * DFF, DFF, DFF, E, SLAB);   \
        else { pg8::Gemm gm{H, DFF, (const bf16*)(F.ws + WS_WDN) + (size_t)(l) * D * DFF, DFF, (nM_), D / 256, DFF, 0, nullptr, nullptr};                    \
            pg8::StaticOrder S; S.init((nM_), D / 256, F.G, (int)blockIdx.x); pg8::gemm_phase<pg8::EpiResid>(ring, gm, S, E); }           \
        CVB;                                                                                                                         \
        if (BOTH((pb) + 2)) GRID_BAR();                                                                                              \
    }

    if (IN(2)) { norm_mod_phase(F, F.in[0], F.in[2], F.in[7] + 0 * D, 0, 0, 1, MT); if (BOTH(2)) GRID_BAR(); }
    if (IN(3)) { pool_phase(F, MT); if (BOTH(3)) GRID_BAR(); }
    if (IN(4)) {
        pg8::Gemm gm{P, D, (const bf16*)(F.ws + WS_WPOOL), 1024, 33, 16, 1024, 2048, nullptr, nullptr};
        pg8::StaticOrder S; S.init(33, 16, F.G, (int)blockIdx.x);
        pg8::EpiResid E{F.in[0], F.in[2], X, XC, modp(F, 0, 0, 2), modp(F, 0, 1, 2), F.in[12], 0};
        pg8::gemm_phase<pg8::EpiResid>(ring, gm, S, E);
        conv_window(F, 10, CV_P0, CV_P4 - CV_P0);
        if (BOTH(4)) GRID_BAR();
    }
    FFN_PHASES(5, 0, 33, MT, X, conv_window(F, 1, CV_P4, CV_P6 - CV_P4), (void)0, 0, BG_CONV)

    if (IN(8)) { norm_mod_phase(F, X, XC, F.in[7] + 1 * D, 1, 0, 1, MT, SLAB, slab_count(DFF)); if (BOTH(8)) GRID_BAR(); }
    if (IN(9)) { s5_phase(F); if (BOTH(9)) GRID_BAR(); }
    if (IN(12)) {
        pg8::Gemm gm{P, D, (const bf16*)(F.ws + WS_WGLU), D, 33, 2 * D / 256, D, 0, nullptr, nullptr};
        pg8::StaticOrder S; S.init(33, 2 * D / 256, F.G, (int)blockIdx.x);
        pg8::EpiGLU E{X, XC, X, XC, modp(F, 1, 0, 2), modp(F, 1, 1, 2)};
        pg8::gemm_phase<pg8::EpiGLU>(ring, gm, S, E);
        conv_window(F, 2, CV_P6, CV_P12 - CV_P6);
        if (BOTH(12)) GRID_BAR();
    }
    FFN_PHASES(13, 1, 33, MT, X, conv_window(F, 3, CV_P12, CV_P14 - CV_P12), (void)0, 0, BG_CONV)

    bf16* QK = (bf16*)(F.ws + WS_QK); bf16* VT = (bf16*)(F.ws + WS_VT);
    if (IN(16)) { norm_mod_phase(F, X, XC, F.in[7] + 2 * D, 2, 0, 1, MT, SLAB, slab_count(DFF)); if (BOTH(16)) GRID_BAR(); }
    if (IN(17)) {
        {
          pg8::Gemm gm{U, D, (const bf16*)(F.ws + WS_WSQKV), D, 33, 20, D, 0, (const bf16*)(F.ws + WS_WSQKV) + (size_t)5120 * D, U};
          pg8::StaticOrder S; S.init(33, 20, F.G, (int)blockIdx.x); S.init2(4, 33);
          pg8::EpiHeadNorm<true> E{QK, 5120, F.in[24], F.in[25], 16, (const float*)(F.ws + WS_ROPE), (LAS float*)(F.lds + MISC_OFF + 4096), QSCALE, VT, MT};
          pg8::gemm_phase<pg8::EpiHeadNorm<true>>(ring, gm, S, E); }
        conv_window(F, 4, CV_P14, CV_P17 - CV_P14);
        if (BOTH(17)) GRID_BAR();
    }
    if (IN(19)) { attn_phase<0>(F, QK, 5120, 4096, VT, MT, F.in[24], F.in[25], F.in[26], true); if (BOTH(19)) GRID_BAR(); }
    if (IN(20)) {
        pg8::EpiResid E{X, XC, X, XC, modp(F, 2, 0, 2), modp(F, 2, 1, 2), nullptr, 0};
        (void)resid_gemm_ctxsplit(ring, F.G, P, D, (const bf16*)(F.ws + WS_WSO), D, D, E, SLAB);
        if (BOTH(20)) GRID_BAR();
    }
    FFN_PHASES(21, 2, 33, MT, X, conv_window(F, 6, CV_P17, CV_P22 - CV_P17), (void)0, slab_count(D), BG_CONV)

    if (IN(24)) { norm_mod_phase(F, X, XC, F.in[7] + 3 * D, 3, 0, 1, MT, SLAB, slab_count(DFF)); if (BOTH(24)) GRID_BAR(); }
    if (IN(25)) {
        {
          pg8::Gemm gm{U, D, (const bf16*)(F.ws + WS_WNQKV), D, 33, 32, D, 0, (const bf16*)(F.ws + WS_WNQKV) + (size_t)8192 * D, U};
          pg8::StaticOrder S; S.init(33, 32, F.G, (int)blockIdx.x); S.init2(16, 33);
          pg8::EpiHeadNorm<false> E{QK, 8192, F.in[29], F.in[30], 16, (const float*)(F.ws + WS_ROPE), (LAS float*)(F.lds + MISC_OFF + 4096), QSCALE, VT, MT};
          pg8::gemm_phase<pg8::EpiHeadNorm<false>>(ring, gm, S, E); }
        conv_window(F, 8, CV_P22, CV_P25 - CV_P22);
        if (BOTH(25)) GRID_BAR();
    }
    if (IN(27)) { attn_phase<1>(F, QK, 8192, 4096, VT, MT, F.in[29], F.in[30], F.in[31], false); if (BOTH(27)) GRID_BAR(); }
    if (IN(28)) {
        pg8::Gemm gm{P, D, (const bf16*)(F.ws + WS_WNO), D, 32, D / 256, D, 0, nullptr, nullptr};
        pg8::StaticOrder S; S.init(32, D / 256, F.G, (int)blockIdx.x);
        pg8::EpiResid E{X, XC, X, XC, modp(F, 3, 0, 2), modp(F, 3, 1, 2), nullptr, 0};
        pg8::gemm_phase<pg8::EpiResid>(ring, gm, S, E);
        if (BOTH(28)) GRID_BAR();
    }
    FFN_PHASES(29, 3, 32, SEQ, F.out, (void)0, (void)0, 0, 0)
#undef IN
#undef BOTH
}

constexpr int N_PHASES = 32;
extern "C" void kernel_launch(void* const* d_in, const int* in_sizes, int n_in, void* d_out, int out_size, void* d_ws, size_t ws_size, hipStream_t stream) {
    static int grid = 0;
    if (grid == 0) {
        if (n_in != 32 || ws_size < WS_END) { fprintf(stderr, "kernel_launch: unexpected n_in %d / ws %zu\n", n_in, ws_size); grid = -1; return; }
        int dev = 0, cus = 0, per_cu = 0;
        if (hipGetDevice(&dev) != hipSuccess || hipDeviceGetAttribute(&cus, hipDeviceAttributeMultiprocessorCount, dev) != hipSuccess) { grid = -1; return; }
        if (hipFuncSetAttribute((const void*)mk_fwd, hipFuncAttributeMaxDynamicSharedMemorySize, LDS_BYTES) != hipSuccess) { fprintf(stderr, "kernel_launch: hipFuncSetAttribute failed\n"); grid = -1; return; }
        if (hipOccupancyMaxActiveBlocksPerMultiprocessor(&per_cu, (const void*)mk_fwd, NWAVES * 64, LDS_BYTES) != hipSuccess || per_cu < 1)
            fprintf(stderr, "kernel_launch: occupancy query reports %d\n", per_cu);
        (void)hipGetLastError();
        grid = cus;
    }
    if (grid < 0) return;
    if (hipMemsetAsync((char*)d_ws + WS_CTL, 0, CTL_ZERO_BYTES, stream) != hipSuccess) return;
    Args a{};
    for (int i = 0; i < 32; ++i) a.in[i] = (const float*)d_in[i];
    a.out = (float*)d_out; a.ws = (unsigned char*)d_ws;
    int li = 0;
#define LAUNCH(lo_, hi_) do { a.ph_lo = (lo_); a.ph_hi = (hi_); a.cvo = 16 * li; a.li = li++; hipLaunchKernelGGL(mk_fwd, dim3(grid), dim3(NWAVES * 64), LDS_BYTES, stream, a); } while (0)
    LAUNCH(0, N_PHASES);
#if PROF_SET == 1
    LAUNCH(0, 1); LAUNCH(1, 2);
#elif PROF_SET == 2
    { const int ph[] = {2, 5, 8, 13, 16, 21, 24, 29, 3}; for (int p : ph) LAUNCH(p, p + 1); }
#elif PROF_SET == 3
    { const int ph[] = {6, 14, 22, 30}; for (int p : ph) LAUNCH(p, p + 1); }
#elif PROF_SET == 4
    { const int ph[] = {31, 7, 15, 23}; for (int p : ph) LAUNCH(p, p + 1); }
#elif PROF_SET == 5
    { const int ph[] = {4, 12, 17, 20, 25, 28}; for (int p : ph) LAUNCH(p, p + 1); }
#elif PROF_SET == 10
    LAUNCH(7, 8);
#elif PROF_SET == 11
    LAUNCH(6, 7);
#elif PROF_SET == 12
    LAUNCH(0, 2);
#elif PROF_SET == 7
    { const int ph[] = {9, 10, 11}; for (int p : ph) LAUNCH(p, p + 1); }
#elif PROF_SET == 8
    { const int ph[] = {19, 27}; for (int p : ph) LAUNCH(p, p + 1); }
#elif PROF_SET == 9
    { const int ph[] = {9}; for (int p : ph) LAUNCH(p, p + 1); }
#elif PROF_SET == 6
    { const int ph[] = {9, 10, 11, 19, 27, 18, 26}; for (int p : ph) LAUNCH(p, p + 1); }
#endif
}
```

```cpp
#include <hip/hip_runtime.h>
#include <cstdio>
#include <cstdint>

#define GAS __attribute__((address_space(1)))
#define LAS __attribute__((address_space(3)))
typedef unsigned short bf16;
typedef short bf16x8 __attribute__((ext_vector_type(8)));
typedef float f32x4 __attribute__((ext_vector_type(4)));
typedef float f32x2 __attribute__((ext_vector_type(2)));
typedef float f32x16 __attribute__((ext_vector_type(16)));
typedef unsigned u32x4 __attribute__((ext_vector_type(4)));
typedef unsigned u32x2 __attribute__((ext_vector_type(2)));
typedef __bf16 bf16x2_t __attribute__((ext_vector_type(2)));

#ifndef MK_PER_PHASE
#define MK_PER_PHASE 0
#endif
#ifndef PROF_SET
#define PROF_SET 0
#endif
#ifndef MK_LAST_PHASE
#define MK_LAST_PHASE 1000
#endif

constexpr int D = 4096, SEQ = 8192, CTXL = 256, MT = SEQ + CTXL, DFF = 11008, RANK = 1024, NWAVES = 8;
constexpr float RMS_EPS = 1e-6f;
constexpr float LOG2E = 1.4426950408889634f;
constexpr float QSCALE = 0.08838834764831845f * LOG2E;

constexpr size_t MiB = 1u << 20;
constexpr size_t WS_CTL = 0, CTL_ZERO_BYTES = 1 * MiB;
constexpr size_t WS_MOD = 1 * MiB;
constexpr size_t WS_HIDP = 2 * MiB;
constexpr size_t WS_ROPE = 3 * MiB;
constexpr size_t WS_X = 4 * MiB;
constexpr size_t WS_U = 136 * MiB;
constexpr size_t WS_P = 202 * MiB;
constexpr size_t WS_H = 268 * MiB;
constexpr size_t WS_QK = 446 * MiB;
constexpr size_t WS_VT = 578 * MiB;
constexpr size_t WS_HC = 644 * MiB;
constexpr size_t WS_HLOC = 776 * MiB;
constexpr size_t WS_MF = 908 * MiB;
constexpr size_t WS_EG = 972 * MiB;
constexpr size_t WS_WGU = 1024 * MiB;
constexpr size_t WS_WDN = 1712 * MiB;
constexpr size_t WS_WPOOL = 2056 * MiB;
constexpr size_t WS_WGLU = 2064 * MiB;
constexpr size_t WS_WSQKV = 2128 * MiB;
constexpr size_t WS_WSO = 2176 * MiB;
constexpr size_t WS_WNQKV = 2208 * MiB;
constexpr size_t WS_WNO = 2304 * MiB;
constexpr size_t WS_SLAB = 2336 * MiB;
constexpr size_t WS_END = 2408 * MiB;
constexpr int CW_BAR = 4096;

constexpr int RING_OFF = 0, RING_BYTES = 131072;
constexpr int MISC_OFF = RING_BYTES;
constexpr int LDS_BYTES = 147456;

#define LDS_WAIT() asm volatile("s_waitcnt lgkmcnt(0)" ::: "memory")
#define VM_WAIT() asm volatile("s_waitcnt vmcnt(0)" ::: "memory")

__device__ __forceinline__ unsigned pk2(float lo, float hi) { f32x2 v = {lo, hi}; bf16x2_t b = __builtin_convertvector(v, bf16x2_t); return __builtin_bit_cast(unsigned, b); }
__device__ __forceinline__ float bf2f(unsigned short b) { return __uint_as_float(((unsigned)b) << 16); }
__device__ __forceinline__ float bflo(unsigned w) { return __uint_as_float(w << 16); }
__device__ __forceinline__ float bfhi(unsigned w) { return __uint_as_float(w & 0xffff0000u); }
__device__ __forceinline__ float wave_sum(float v) {
#pragma unroll
    for (int o = 1; o < 64; o <<= 1) v += __shfl_xor(v, o);
    return v;
}
__device__ __forceinline__ float fast_sigmoid(float a) { return __frcp_rn(1.0f + __expf(-a)); }
__device__ __forceinline__ float silu_f(float a) { return a * fast_sigmoid(a); }

#define XB_TMO      128
#define XB_XCNT(j)  (256  + 64 * (j))
#define XB_XSUB(j)  (1280 + 64 * (j))
#define XB_XGEN(j)  (2304 + 64 * (j))
#define XB_TOP      3328
#define XB_TOPGEN   3392
#define XCD_BAR_WORDS 3456
#define XB_SPIN_CAP (1u << 23)

__device__ __forceinline__ unsigned xb_ld(unsigned* p)              { return __hip_atomic_load(p, __ATOMIC_RELAXED, __HIP_MEMORY_SCOPE_AGENT); }
__device__ __forceinline__ unsigned xb_add(unsigned* p, unsigned v) { return __hip_atomic_fetch_add(p, v, __ATOMIC_RELAXED, __HIP_MEMORY_SCOPE_AGENT); }
__device__ __forceinline__ unsigned xb_xcc_id() { return (unsigned)__builtin_amdgcn_s_getreg((3 << 11) | 20) & 0xFu; }
#define XB_SPIN(cond, bar) do { unsigned _sp = 0; while (cond) { __builtin_amdgcn_s_sleep(1); \
    if ((++_sp & 255u) == 0u) { if (xb_ld(&(bar)[XB_TMO])) break; if (_sp > XB_SPIN_CAP) { atomicAdd(&(bar)[XB_TMO], 1u); break; } } } } while (0)

struct XcdBarrier { unsigned* bar; unsigned x; volatile LAS unsigned* st; };

__device__ __forceinline__ XcdBarrier xcd_barrier_post(unsigned* bar, volatile LAS unsigned* st) {
    XcdBarrier b; b.bar = bar; b.x = xb_xcc_id(); b.st = st;
    if (threadIdx.x == 0) (void)xb_add(&bar[XB_XCNT(b.x)], 1u);
    return b;
}
__device__ __forceinline__ void xcd_barrier_complete(unsigned* bar, unsigned x, unsigned& nloc, unsigned& nx) {
    const unsigned G = gridDim.x * gridDim.y * gridDim.z;
    unsigned sum, cnt, mine, sp = 0u;
    for (;;) {
        sum = 0u; cnt = 0u; mine = 0u;
#pragma unroll
        for (unsigned j = 0; j < 16; ++j) { const unsigned c = xb_ld(&bar[XB_XCNT(j)]); sum += c; cnt += (c > 0u) ? 1u : 0u; mine = (j == x) ? c : mine; }
        if (sum == G) break;
        __builtin_amdgcn_s_sleep(1);
        if ((++sp & 255u) == 0u) { if (xb_ld(&bar[XB_TMO])) break; if (sp > XB_SPIN_CAP) { atomicAdd(&bar[XB_TMO], 1u); break; } }
    }
    nloc = mine > 0u ? mine : 1u; nx = cnt > 0u ? cnt : 1u;
}
__device__ __forceinline__ void xcd_barrier(const XcdBarrier& b) {
    asm volatile("s_waitcnt vmcnt(0)" ::: "memory");
    __syncthreads();
    if (threadIdx.x == 0) {
        unsigned* bar = b.bar;
        __builtin_amdgcn_s_waitcnt(0);
        unsigned nloc = b.st[0], nx = b.st[1];
        if (nloc == 0u) { xcd_barrier_complete(bar, b.x, nloc, nx); b.st[0] = nloc; b.st[1] = nx; }
        const unsigned old = xb_add(&bar[XB_XSUB(b.x)], 1u);
        const unsigned gen = old / nloc;
        if (old + 1u == (gen + 1u) * nloc) {
            __builtin_amdgcn_fence(__ATOMIC_RELEASE, "agent");
            asm volatile("s_waitcnt vmcnt(0)" ::: "memory");
            const unsigned og = xb_add(&bar[XB_TOP], 1u);
            const unsigned tg = og / nx;
            if (og + 1u == (tg + 1u) * nx) xb_add(&bar[XB_TOPGEN], 1u);
            else XB_SPIN(xb_ld(&bar[XB_TOPGEN]) == tg, bar);
            __builtin_amdgcn_fence(__ATOMIC_ACQUIRE, "agent");
            xb_add(&bar[XB_XGEN(b.x)], 1u);
            asm volatile("s_waitcnt vmcnt(0)" ::: "memory");
        } else {
            XB_SPIN(xb_ld(&bar[XB_XGEN(b.x)]) == gen, bar);
            __builtin_amdgcn_fence(__ATOMIC_ACQUIRE, "agent");
            asm volatile("s_waitcnt vmcnt(0)" ::: "memory");
        }
    }
    __syncthreads();
}

namespace pg8 {
constexpr int BM = 256, BK = 64, HALF = 128, HTB = HALF * BK * 2, STAGE_BYTES = 8 * HTB, NXCD = 8, WGM = 8;
__host__ __device__ __forceinline__ int lds_byte(int r, int c) { const int st = (r >> 4) * 2 + (c >> 5), rr = r & 15, cc = c & 31, ob = rr * 64 + cc * 2; return st * 1024 + (ob ^ (((ob >> 9) & 1) << 5)); }
__host__ __device__ __forceinline__ void stage_rc(int b, int& R, int& C) { const int st = b / 1024, sb = b % 1024, swz = sb ^ (((sb >> 9) & 1) << 5); R = (st >> 1) * 16 + swz / 64; C = (st & 1) * 32 + (swz % 64) / 2; }
__host__ __device__ __forceinline__ int perm32(int rho) { const int n = rho >> 4, i = rho & 15; return 8 * (i >> 2) + 4 * n + (i & 3); }

struct Unit { int pm, pn, kt0, sidx, which; };
struct Gemm { const bf16* A; long lda; const bf16* Bt; long ldb; int nM, nN, K; long agrp; const bf16* A2; const bf16* Bt2; };

struct StaticOrder {
    int nM, nN, nwg, G, c, first, count, SF, kofs, nkt, nM2, nN2, nwg2;
    __host__ __device__ void init(int nM_, int nN_, int G_, int c_, int first_ = 0, int count_ = -1, int SF_ = 1, int kofs_ = 0, int nkt_ = 0) {
        nM = nM_; nN = nN_; nwg = nM * nN; G = G_; c = c_; first = first_; count = count_ < 0 ? nwg : count_; SF = SF_; kofs = kofs_; nkt = nkt_; nM2 = 0; nN2 = 1; nwg2 = 0; }
    __host__ __device__ void init2(int nM2_, int nN2_) { nM2 = nM2_; nN2 = nN2_; nwg2 = nM2 * nN2; }
    __host__ __device__ static void tile_of(int wgid, int nwg_, int nM_, int nN_, Unit& u) {
        { const int q = nwg_ / NXCD, r = nwg_ % NXCD, xcd = wgid % NXCD, off = wgid / NXCD; wgid = (xcd < r ? xcd * (q + 1) : r * (q + 1) + (xcd - r) * q) + off; }
        const int nig = WGM * nN_, gid = wgid / nig, fm = gid * WGM, gsz = (nM_ - fm) < WGM ? (nM_ - fm) : WGM;
        u.pm = fm + ((wgid % nig) % gsz); u.pn = (wgid % nig) / gsz; }
    __host__ __device__ bool next(int i, Unit& u) const {
        const long idx = (long)i * G + c; u.which = 0;
        if (idx >= (long)count * SF) { const long j = idx - (long)count * SF; if (j >= nwg2) return false; u.which = 1; u.kt0 = 0; u.sidx = 0; tile_of((int)j, nwg2, nM2, nN2, u); return true; }
        u.sidx = (int)(idx % SF); u.kt0 = kofs + u.sidx * nkt; tile_of(first + (int)(idx / SF), nwg, nM, nN, u); return true;
    }
};

template <class Epi, bool ALIGN_EPI = true>
__device__ __forceinline__ void gemm_phase(LAS unsigned char* lds, const Gemm g, const StaticOrder& S, const Epi& E) {
    const int tid = threadIdx.x, wid = __builtin_amdgcn_readfirstlane(tid >> 6), lane = tid & 63, wr = wid >> 2, wc = wid & 3, fr = lane & 15, fq = lane >> 4;
    const int nt = g.K / BK;
    unsigned voffA[2], voffB[2];
#pragma unroll
    for (int i = 0; i < 2; ++i) { int R, C; stage_rc(tid * 16 + i * 8192, R, C); const int Rb = Epi::PERM ? ((R & ~31) + perm32(R & 31)) : R;
        voffA[i] = (unsigned)((long)R * g.lda + C) * 2u; voffB[i] = (unsigned)((long)Rb * g.ldb + C) * 2u; }
    const size_t kstep = (size_t)(BK * 2);
    const size_t hstepA = (size_t)HALF * g.lda * 2, hstepB = (size_t)HALF * g.ldb * 2;
    const size_t tstepA = 2 * hstepA, tstepB = 2 * hstepB;
    const unsigned ldsw = (unsigned)wid * 1024u;
    const int aoff = lds_byte(wr * 64 + fr, fq * 8), boff = lds_byte(wc * 32 + fr, fq * 8);
#define PG8_SA(b, h) (((b) * 2 + (h)) * HTB)
#define PG8_SB(b, h) ((4 + (b) * 2 + (h)) * HTB)
#define PG8_STAGE(bufoff, gbase, voff) do { _Pragma("unroll") for (int _i = 0; _i < 2; ++_i) \
        __builtin_amdgcn_global_load_lds((const unsigned*)((const char*)(gbase) + (voff)[_i]), (LAS unsigned*)(lds + (bufoff) + ldsw + _i * 8192), 16, 0, 0); } while (0)
#define PG8_LDA(dst, b, h) do { _Pragma("unroll") for (int m = 0; m < 4; ++m) _Pragma("unroll") for (int k = 0; k < 2; ++k) dst[m][k] = *(const LAS bf16x8*)(lds + PG8_SA(b, h) + aoff + m * 2048 + k * 1024); } while (0)
#define PG8_LDB(dst, b, h) do { _Pragma("unroll") for (int n = 0; n < 2; ++n) _Pragma("unroll") for (int k = 0; k < 2; ++k) dst[n][k] = *(const LAS bf16x8*)(lds + PG8_SB(b, h) + boff + n * 2048 + k * 1024); } while (0)
#define PG8_MMA(ai, bj, At, Bt) do { __builtin_amdgcn_s_setprio(1); _Pragma("unroll") for (int m = 0; m < 4; ++m) _Pragma("unroll") for (int n = 0; n < 2; ++n) _Pragma("unroll") for (int k = 0; k < 2; ++k) \
        acc[ai][bj][m][n] = __builtin_amdgcn_mfma_f32_16x16x32_bf16(Bt[n][k], At[m][k], acc[ai][bj][m][n], 0, 0, 0); __builtin_amdgcn_s_setprio(0); } while (0)
#define PG8_WAIT_V(n) asm volatile("s_waitcnt vmcnt(" #n ")" ::: "memory")
#define PG8_WAIT_L(n) asm volatile("s_waitcnt lgkmcnt(" #n ")" ::: "memory")
#define PG8_BAR __builtin_amdgcn_s_barrier()
#define PG8_SCHED __builtin_amdgcn_sched_barrier(0)
    Unit cur, nxt; int ui = 0;
    if (!S.next(0, cur)) return;
    f32x4 acc[2][2][4][2];
#pragma unroll
    for (int a = 0; a < 2; ++a)
#pragma unroll
        for (int b = 0; b < 2; ++b)
#pragma unroll
            for (int m = 0; m < 4; ++m)
#pragma unroll
                for (int n = 0; n < 2; ++n) acc[a][b][m][n] = (f32x4){0.f, 0.f, 0.f, 0.f};
    bf16x8 At[4][2], B0[2][2], B1[2][2];
    const char* cA = (const char*)(cur.which ? g.A2 : g.A) + (size_t)cur.pm * tstepA + (size_t)(cur.pn >> 2) * g.agrp + (size_t)cur.kt0 * kstep; const char* cB = (const char*)(cur.which ? g.Bt2 : g.Bt) + (size_t)cur.pn * tstepB + (size_t)cur.kt0 * kstep;
    PG8_STAGE(PG8_SB(0, 0), cB, voffB); PG8_STAGE(PG8_SB(0, 1), cB + hstepB, voffB); PG8_STAGE(PG8_SA(0, 0), cA, voffA); PG8_STAGE(PG8_SA(0, 1), cA + hstepA, voffA);
    if (wr == 1) PG8_BAR;
    PG8_WAIT_V(2); PG8_BAR;
    PG8_STAGE(PG8_SB(1, 0), cB + kstep, voffB); PG8_STAGE(PG8_SA(1, 0), cA + kstep, voffA); PG8_STAGE(PG8_SB(1, 1), cB + hstepB + kstep, voffB);
    PG8_WAIT_V(6); PG8_BAR;
    for (;;) {
        const bool has_next = S.next(ui + 1, nxt);
        const char* nA = has_next ? (const char*)(nxt.which ? g.A2 : g.A) + (size_t)nxt.pm * tstepA + (size_t)(nxt.pn >> 2) * g.agrp + (size_t)nxt.kt0 * kstep : cA; const char* nB = has_next ? (const char*)(nxt.which ? g.Bt2 : g.Bt) + (size_t)nxt.pn * tstepB + (size_t)nxt.kt0 * kstep : cB;
        asm volatile(".p2align 8" ::: "memory");
        for (int t = 0; t < nt; t += 2) {
            const bool last = (t == nt - 2);
            const char* a1 = cA + (size_t)(t + 1) * kstep;
            const char* a2 = last ? nA : cA + (size_t)(t + 2) * kstep; const char* b2 = last ? nB : cB + (size_t)(t + 2) * kstep;
            const char* a3 = a2 + kstep; const char* b3 = b2 + kstep;
            PG8_LDB(B0, 0, 0); PG8_LDB(B1, 0, 1); PG8_SCHED; PG8_LDA(At, 0, 0); PG8_STAGE(PG8_SA(1, 1), a1 + hstepA, voffA);
            PG8_WAIT_V(8); PG8_WAIT_L(0); PG8_BAR; PG8_MMA(0, 0, At, B0); PG8_MMA(0, 1, At, B1); PG8_BAR; PG8_SCHED;
            PG8_LDA(At, 0, 1); PG8_STAGE(PG8_SB(0, 0), b2, voffB); PG8_STAGE(PG8_SB(0, 1), b2 + hstepB, voffB); PG8_STAGE(PG8_SA(0, 0), a2, voffA);
            PG8_WAIT_V(8); PG8_WAIT_L(0); PG8_BAR; PG8_MMA(1, 0, At, B0); PG8_MMA(1, 1, At, B1); PG8_BAR; PG8_SCHED;
            PG8_LDB(B0, 1, 0); PG8_LDB(B1, 1, 1); PG8_SCHED; PG8_LDA(At, 1, 0); PG8_STAGE(PG8_SA(0, 1), a2 + hstepA, voffA);
            PG8_WAIT_V(8); PG8_WAIT_L(0); PG8_BAR; PG8_MMA(0, 0, At, B0); PG8_MMA(0, 1, At, B1); PG8_BAR; PG8_SCHED;
            PG8_LDA(At, 1, 1); PG8_STAGE(PG8_SB(1, 0), b3, voffB); PG8_STAGE(PG8_SB(1, 1), b3 + hstepB, voffB); PG8_STAGE(PG8_SA(1, 0), a3, voffA);
            PG8_WAIT_V(8); PG8_WAIT_L(0); PG8_BAR; PG8_MMA(1, 0, At, B0); PG8_MMA(1, 1, At, B1); PG8_BAR; PG8_SCHED;
        }
        if constexpr (ALIGN_EPI) { if (wr == 0) PG8_BAR; }
        E(acc, cur, wr, wc, fr, fq);
        if (!has_next) break;
#pragma unroll
        for (int a = 0; a < 2; ++a)
#pragma unroll
            for (int b = 0; b < 2; ++b)
#pragma unroll
                for (int m = 0; m < 4; ++m)
#pragma unroll
                    for (int n = 0; n < 2; ++n) acc[a][b][m][n] = (f32x4){0.f, 0.f, 0.f, 0.f};
        cur = nxt; cA = nA; cB = nB; ++ui;
        if constexpr (ALIGN_EPI) { if (wr == 1) PG8_BAR; }
    }
    PG8_WAIT_V(0);
    if constexpr (!ALIGN_EPI) { if (wr == 0) PG8_BAR; }
    PG8_BAR;
#undef PG8_SA
#undef PG8_SB
#undef PG8_STAGE
#undef PG8_LDA
#undef PG8_LDB
#undef PG8_MMA
#undef PG8_WAIT_V
#undef PG8_WAIT_L
#undef PG8_BAR
#undef PG8_SCHED
}

struct EpiBf16 {
    static constexpr bool PERM = true;
    bf16* O; long ldc;
    __device__ __forceinline__ void operator()(const f32x4 (&acc)[2][2][4][2], const Unit& u, int wr, int wc, int fr, int fq) const {
        const int row0 = u.pm * BM + wr * 64 + fr, col0 = u.pn * BM + wc * 32 + 8 * fq;
#pragma unroll
        for (int ai = 0; ai < 2; ++ai)
#pragma unroll
            for (int m = 0; m < 4; ++m) { bf16* rowp = O + (size_t)(row0 + ai * HALF + m * 16) * ldc + col0;
#pragma unroll
                for (int bj = 0; bj < 2; ++bj) { const f32x4 v0 = acc[ai][bj][m][0], v1 = acc[ai][bj][m][1];
                    u32x4 w; w.x = pk2(v0[0], v0[1]); w.y = pk2(v0[2], v0[3]); w.z = pk2(v1[0], v1[1]); w.w = pk2(v1[2], v1[3]);
                    *(u32x4*)(rowp + bj * HALF) = w; } }
    }
};
struct EpiSwiGLU {
    static constexpr bool PERM = true;
    bf16* H; long ldh;
    __device__ __forceinline__ void operator()(const f32x4 (&acc)[2][2][4][2], const Unit& u, int wr, int wc, int fr, int fq) const {
        const int row0 = u.pm * BM + wr * 64 + fr, col0 = u.pn * HALF + wc * 32 + 8 * fq;
#pragma unroll
        for (int ai = 0; ai < 2; ++ai)
#pragma unroll
            for (int m = 0; m < 4; ++m) { bf16* rowp = H + (size_t)(row0 + ai * HALF + m * 16) * ldh + col0;
                float h[8];
#pragma unroll
                for (int n = 0; n < 2; ++n)
#pragma unroll
                    for (int j = 0; j < 4; ++j) h[4 * n + j] = silu_f(acc[ai][0][m][n][j]) * acc[ai][1][m][n][j];
                u32x4 w; w.x = pk2(h[0], h[1]); w.y = pk2(h[2], h[3]); w.z = pk2(h[4], h[5]); w.w = pk2(h[6], h[7]);
                *(u32x4*)rowp = w; }
    }
};
struct EpiResid {
    static constexpr bool PERM = false;
    const float* base_lat; const float* base_ctx; float* out_lat; float* out_ctx; const float* gate_lat; const float* gate_ctx; const float* cs; int col_off;
    __device__ __forceinline__ void operator()(const f32x4 (&acc)[2][2][4][2], const Unit& u, int wr, int wc, int fr, int fq) const {
        const bool isc = u.pm >= 32;
        const float* base = isc ? base_ctx : base_lat; float* out = isc ? out_ctx : out_lat; const float* gate = isc ? gate_ctx : gate_lat;
        const int row0 = (isc ? u.pm - 32 : u.pm) * BM + wr * 64 + fr, col0 = col_off + u.pn * BM + wc * 32 + 4 * fq;
        f32x4 gv[2][2];
#pragma unroll
        for (int bj = 0; bj < 2; ++bj)
#pragma unroll
            for (int n = 0; n < 2; ++n) { gv[bj][n] = *(const f32x4*)(gate + col0 + bj * HALF + n * 16); if (cs) gv[bj][n] *= *(const f32x4*)(cs + col0 + bj * HALF + n * 16); }
#pragma unroll
        for (int ai = 0; ai < 2; ++ai)
#pragma unroll
            for (int m = 0; m < 4; ++m) { const size_t off = (size_t)(row0 + ai * HALF + m * 16) * D + col0;
#pragma unroll
                for (int bj = 0; bj < 2; ++bj)
#pragma unroll
                    for (int n = 0; n < 2; ++n) { const f32x4 bs = *(const f32x4*)(base + off + bj * HALF + n * 16); *(f32x4*)(out + off + bj * HALF + n * 16) = bs + gv[bj][n] * acc[ai][bj][m][n]; }
                asm volatile("" ::: "memory"); }
    }
};
struct EpiSlab {
    static constexpr bool PERM = false;
    float* slab; const float* gate; int sbase;
    __device__ __forceinline__ void operator()(const f32x4 (&acc)[2][2][4][2], const Unit& u, int wr, int wc, int fr, int fq) const {
        const int row0 = wr * 64 + fr, col0 = u.pn * BM + wc * 32 + 4 * fq;
        float* out = slab + (size_t)(sbase + u.sidx) * CTXL * D;
        f32x4 gv[2][2];
#pragma unroll
        for (int bj = 0; bj < 2; ++bj)
#pragma unroll
            for (int n = 0; n < 2; ++n) gv[bj][n] = *(const f32x4*)(gate + col0 + bj * HALF + n * 16);
#pragma unroll
        for (int ai = 0; ai < 2; ++ai)
#pragma unroll
            for (int m = 0; m < 4; ++m) { const size_t off = (size_t)(row0 + ai * HALF + m * 16) * D + col0;
#pragma unroll
                for (int bj = 0; bj < 2; ++bj)
#pragma unroll
                    for (int n = 0; n < 2; ++n) *(f32x4*)(out + off + bj * HALF + n * 16) = gv[bj][n] * acc[ai][bj][m][n]; }
    }
};
struct EpiGLU {
    static constexpr bool PERM = false;
    const float* base_lat; const float* base_ctx; float* out_lat; float* out_ctx; const float* gate_lat; const float* gate_ctx;
    __device__ __forceinline__ void operator()(const f32x4 (&acc)[2][2][4][2], const Unit& u, int wr, int wc, int fr, int fq) const {
        const bool isc = u.pm >= 32;
        const float* base = isc ? base_ctx : base_lat; float* out = isc ? out_ctx : out_lat; const float* gate = isc ? gate_ctx : gate_lat;
        const int row0 = (isc ? u.pm - 32 : u.pm) * BM + wr * 64 + fr, col0 = u.pn * HALF + wc * 32 + 4 * fq;
        f32x4 gv[2];
#pragma unroll
        for (int n = 0; n < 2; ++n) gv[n] = *(const f32x4*)(gate + col0 + n * 16);
#pragma unroll
        for (int ai = 0; ai < 2; ++ai)
#pragma unroll
            for (int m = 0; m < 4; ++m) { const size_t off = (size_t)(row0 + ai * HALF + m * 16) * D + col0;
#pragma unroll
                for (int n = 0; n < 2; ++n) { const f32x4 bs = *(const f32x4*)(base + off + n * 16); const f32x4 a = acc[ai][0][m][n], gt = acc[ai][1][m][n]; f32x4 v;
#pragma unroll
                    for (int j = 0; j < 4; ++j) v[j] = a[j] * fast_sigmoid(gt[j]);
                    *(f32x4*)(out + off + n * 16) = bs + gv[n] * v; }
                asm volatile("" ::: "memory"); }
    }
};
template <bool ROPE> struct EpiHeadNorm {
    static constexpr bool PERM = true;
    bf16* O; long ldc; const float* qg; const float* kg; int nq_tiles; const float* ropetab; LAS float* stats; float qscale; bf16* O1; long ldc1;
    __device__ __forceinline__ void operator()(const f32x4 (&acc)[2][2][4][2], const Unit& u, int wr, int wc, int fr, int fq) const {
        const int rloc0 = wr * 64 + fr;
        if (u.which) {
            const int row0p = u.pm * BM + rloc0, col0p = u.pn * BM + wc * 32 + 8 * fq;
#pragma unroll
            for (int ai = 0; ai < 2; ++ai)
#pragma unroll
                for (int m = 0; m < 4; ++m) { bf16* rowp = O1 + (size_t)(row0p + ai * HALF + m * 16) * ldc1 + col0p;
#pragma unroll
                    for (int bj = 0; bj < 2; ++bj) { const f32x4 v0 = acc[ai][bj][m][0], v1 = acc[ai][bj][m][1];
                        u32x4 w; w.x = pk2(v0[0], v0[1]); w.y = pk2(v0[2], v0[3]); w.z = pk2(v1[0], v1[1]); w.w = pk2(v1[2], v1[3]);
                        *(u32x4*)(rowp + bj * HALF) = w; } }
            return;
        }
#pragma unroll
        for (int ai = 0; ai < 2; ++ai)
#pragma unroll
            for (int m = 0; m < 4; ++m)
#pragma unroll
                for (int bj = 0; bj < 2; ++bj) { const f32x4 v0 = acc[ai][bj][m][0], v1 = acc[ai][bj][m][1];
                    float ss = (v0[0] * v0[0] + v0[1] * v0[1]) + (v0[2] * v0[2] + v0[3] * v0[3]) + (v1[0] * v1[0] + v1[1] * v1[1]) + (v1[2] * v1[2] + v1[3] * v1[3]);
                    ss += __shfl_xor(ss, 16); ss += __shfl_xor(ss, 32);
                    if (fq == 0) stats[((ai * HALF + m * 16 + rloc0) * 2 + bj) * 4 + wc] = ss; }
        asm volatile("s_waitcnt lgkmcnt(0)" ::: "memory"); __builtin_amdgcn_s_barrier(); asm volatile("" ::: "memory");
        const bool isq = u.pn < nq_tiles; const float* gain = isq ? qg : kg; const float osc = isq ? qscale : 1.0f;
        const int g = 4 * wc + fq, i0 = 4 * (g & 7);
        float ga[4], gb[4];
#pragma unroll
        for (int j = 0; j < 4; ++j) { if (ROPE) { ga[j] = gain[(g < 8 ? 0 : 64) + i0 + j] * osc; gb[j] = gain[(g < 8 ? 32 : 96) + i0 + j] * osc; } else { ga[j] = gain[8 * g + j] * osc; gb[j] = gain[8 * g + 4 + j] * osc; } }
        const int row0 = u.pm * BM + rloc0, col0 = u.pn * BM + wc * 32 + 8 * fq;
#pragma unroll
        for (int ai = 0; ai < 2; ++ai)
#pragma unroll
            for (int m = 0; m < 4; ++m) { const int row = row0 + ai * HALF + m * 16; bf16* rowp = O + (size_t)row * ldc + col0;
                f32x4 cs = {1.f, 1.f, 1.f, 1.f}, sn = {0.f, 0.f, 0.f, 0.f};
                if (ROPE) { if (row < SEQ) { const int pos = (g < 8) ? (row >> 6) : (row & 63); const float* tp = ropetab + ((size_t)pos * 32 + i0) * 2;
                        const f32x4 t0 = *(const f32x4*)tp, t1 = *(const f32x4*)(tp + 4); cs = (f32x4){t0[0], t0[2], t1[0], t1[2]}; sn = (f32x4){t0[1], t0[3], t1[1], t1[3]}; } }
#pragma unroll
                for (int bj = 0; bj < 2; ++bj) { const f32x4 st = *(const LAS f32x4*)(stats + ((ai * HALF + m * 16 + rloc0) * 2 + bj) * 4);
                    const float rs = rsqrtf(((st[0] + st[1]) + (st[2] + st[3])) * (1.0f / 128.0f) + RMS_EPS);
                    const f32x4 v0 = acc[ai][bj][m][0], v1 = acc[ai][bj][m][1]; float oa[4], ob[4];
#pragma unroll
                    for (int j = 0; j < 4; ++j) { const float ya = v0[j] * rs * ga[j], yb = v1[j] * rs * gb[j];
                        if (ROPE) { oa[j] = ya * cs[j] - yb * sn[j]; ob[j] = yb * cs[j] + ya * sn[j]; } else { oa[j] = ya; ob[j] = yb; } }
                    u32x4 w; w.x = pk2(oa[0], oa[1]); w.y = pk2(oa[2], oa[3]); w.z = pk2(ob[0], ob[1]); w.w = pk2(ob[2], ob[3]);
                    *(u32x4*)(rowp + bj * HALF) = w; } }
    }
};
}

struct Frame {
    LAS unsigned char* lds;
    int tid, lane, wave, vcu, G, gw, NGW;
    const float* in[32];
    float* out; unsigned char* ws; int cvo;
};
struct Args { const float* in[32]; float* out; unsigned char* ws; int ph_lo, ph_hi, li, cvo; };

__device__ __forceinline__ float* modp(const Frame& F, int l, int v, int i) { return (float*)(F.ws + WS_MOD) + ((size_t)(l * 2 + v) * 6 + i) * D; }

constexpr int NSLAB_MAX = 17;
__host__ __device__ constexpr int slab_count(int Ktot) { int ntk = Ktot / 64, SF = 16; if (SF > ntk / 4) SF = ntk / 4; int nkt = (ntk / SF) & ~1, rem = ntk - SF * nkt; if (rem == 2) { nkt -= 2; rem += 2 * SF; } return SF + (rem > 0 ? 1 : 0); }
__device__ __forceinline__ int resid_gemm_ctxsplit(LAS unsigned char* ring, int G, const bf16* A, long lda, const bf16* Bt, long ldb, int Ktot, const pg8::EpiResid& E, float* slab) {
    { pg8::Gemm gm{A, lda, Bt, ldb, 32, D / 256, Ktot, 0, nullptr, nullptr}; pg8::StaticOrder S; S.init(32, D / 256, G, (int)blockIdx.x); pg8::gemm_phase<pg8::EpiResid>(ring, gm, S, E); }
    const int ntk = Ktot / 64; int SF = 16; if (SF > ntk / 4) SF = ntk / 4;
    int nkt = (ntk / SF) & ~1, rem = ntk - SF * nkt; if (rem == 2) { nkt -= 2; rem += 2 * SF; }
    const bf16* Ac = A + (size_t)SEQ * lda;
    { pg8::Gemm gm{Ac, lda, Bt, ldb, 1, D / 256, nkt * 64, 0, nullptr, nullptr}; pg8::StaticOrder S; S.init(1, D / 256, G, (int)blockIdx.x, 0, D / 256, SF, 0, nkt); pg8::EpiSlab ES{slab, E.gate_ctx, 0}; pg8::gemm_phase<pg8::EpiSlab>(ring, gm, S, ES); }
    if (rem > 0) { pg8::Gemm gm{Ac, lda, Bt, ldb, 1, D / 256, rem * 64, 0, nullptr, nullptr}; pg8::StaticOrder S; S.init(1, D / 256, G, (int)((blockIdx.x + 128) % G), 0, D / 256, 1, SF * nkt, rem); pg8::EpiSlab ES{slab, E.gate_ctx, SF}; pg8::gemm_phase<pg8::EpiSlab>(ring, gm, S, ES); }
    return SF + (rem > 0 ? 1 : 0);
}

__device__ __forceinline__ void transpose_item(const float* W, long ldw, int k0, int n0, bf16* WT, long ldt, int dest_row0, LAS float* scr, int lane, bool spread = false) {
    {
        f32x4 t[8];
#pragma unroll
        for (int i = 0; i < 8; ++i) t[i] = __builtin_nontemporal_load((const f32x4*)&W[(size_t)(k0 + 8 * i + (lane >> 3)) * ldw + n0 + 4 * (lane & 7)]);
#pragma unroll
        for (int i = 0; i < 8; ++i) { LAS float* d = scr + (8 * i + (lane >> 3)) * 33 + 4 * (lane & 7); d[0] = t[i][0]; d[1] = t[i][1]; d[2] = t[i][2]; d[3] = t[i][3]; }
    }
    LDS_WAIT(); asm volatile("" ::: "memory");
    const int c = lane & 7;
#pragma unroll
    for (int j = 0; j < 4; ++j) { const int n = (lane >> 3) + 8 * j; const LAS float* s = scr + (8 * c) * 33 + n;
        u32x4 o; o.x = pk2(s[0 * 33], s[1 * 33]); o.y = pk2(s[2 * 33], s[3 * 33]); o.z = pk2(s[4 * 33], s[5 * 33]); o.w = pk2(s[6 * 33], s[7 * 33]);
        __builtin_nontemporal_store(o, (u32x4*)(WT + (size_t)(dest_row0 + (spread ? 8 * (n >> 2) + (n & 3) : n)) * ldt + k0 + 8 * c)); }
    LDS_WAIT(); asm volatile("" ::: "memory");
}
__device__ __forceinline__ void tr_plain(const float* W, int K, int N, bf16* WT, int it, LAS float* scr, int lane) {
    const int nblk = N / 32, kb = it / nblk, nb = it % nblk;
    transpose_item(W, N, 64 * kb, 32 * nb, WT, K, 32 * nb, scr, lane);
}
__device__ __forceinline__ void tr_inter(const float* W, int K, int NH, bf16* WT, int it, LAS float* scr, int lane) {
    const int nblk = 2 * NH / 32, kb = it / nblk, nb = it % nblk, n0 = 32 * nb, half = n0 / NH, j = n0 % NH;
    transpose_item(W, 2 * NH, 64 * kb, n0, WT, K, (j / 128) * 256 + half * 128 + (j % 128), scr, lane);
}

__device__ __forceinline__ void p0_prologue(Frame& F) {
    LAS float* sc = (LAS float*)(F.lds + RING_OFF);
    for (int i = F.tid; i < 2 * D; i += NWAVES * 64) { const float v = (i < D) ? F.in[1][i] : F.in[3][i - D]; sc[i] = silu_f(v); }
    __syncthreads();
    for (int it = F.gw; it < 2048; it += F.NGW) {
        const int l = it >> 9, ks = (it >> 4) & 31, rb = it & 15, r = rb * 64 + F.lane;
        const float* W = F.in[4] + ((size_t)l * D + ks * 128) * RANK + r;
        float a0 = 0.f, a1 = 0.f;
#pragma unroll 16
        for (int k = 0; k < 128; ++k) { const float w = __builtin_nontemporal_load(&W[(size_t)k * RANK]); a0 += sc[ks * 128 + k] * w; a1 += sc[D + ks * 128 + k] * w; }
        float* hp = (float*)(F.ws + WS_HIDP) + ((size_t)(l * 32 + ks) * 2) * RANK + r;
        hp[0] = a0; hp[RANK] = a1;
    }
    __syncthreads();
    for (int e = F.gw * 64 + F.lane; e < 128 * 32; e += F.NGW * 64) { float sn, cs; sincosf((float)(e >> 5) * exp2f(-(float)(e & 31) * (13.287712379549449f / 32.0f)), &sn, &cs);
        ((float*)(F.ws + WS_ROPE))[2 * e] = cs; ((float*)(F.ws + WS_ROPE))[2 * e + 1] = sn; }
}

constexpr int I_GU = 64 * (2 * DFF / 32), I_DN = (DFF / 64) * (D / 32), I_POOL = 16 * 32, I_GLU = 64 * (2 * D / 32);
constexpr int I_SQKV = 64 * (6144 / 32), I_O = 64 * (D / 32), I_NQKV = 64 * (12288 / 32);
constexpr int CV_TOTAL = 4 * I_POOL + 4 * I_GU + 4 * I_DN + I_GLU + I_SQKV + 2 * I_O + I_NQKV;
constexpr int CV_P0 = 2048  , CV_P4 = 46080  , CV_P6 = 112080  ,
              CV_P12 = 150528  , CV_P14 = 215040  , CV_P17 = 237056  ,
              CV_P22 = 303056  , CV_P25 = CV_TOTAL  ;
constexpr int BG_CONV = 16;
static_assert(CV_P4 == 4 * I_POOL + I_GU && CV_P12 == 4 * I_POOL + 2 * I_GU + 2 * I_DN + I_GLU && CV_TOTAL == 335872, "conversion list");
constexpr int CW_CONV = 1024;
__device__ __forceinline__ void conv_item(Frame& F, int idx, LAS float* scr) {
    int r = idx;
    if (r < 4 * I_POOL) { const int g = r / I_POOL; tr_plain(F.in[11] + (size_t)g * 1024 * 1024, 1024, 1024, (bf16*)(F.ws + WS_WPOOL) + (size_t)g * 1024 * 1024, r % I_POOL, scr, F.lane); return; } r -= 4 * I_POOL;
#define CV_GU(l) if (r < I_GU) { tr_inter(F.in[9] + (size_t)(l) * D * 2 * DFF, D, DFF, (bf16*)(F.ws + WS_WGU) + (size_t)(l) * 2 * DFF * D, r, scr, F.lane); return; } r -= I_GU;
#define CV_DN(l) if (r < I_DN) { tr_plain(F.in[10] + (size_t)(l) * DFF * D, DFF, D, (bf16*)(F.ws + WS_WDN) + (size_t)(l) * D * DFF, r, scr, F.lane); return; } r -= I_DN;
    CV_GU(0) CV_DN(0)
    if (r < I_GLU) { tr_inter(F.in[21], D, D, (bf16*)(F.ws + WS_WGLU), r, scr, F.lane); return; } r -= I_GLU;
    CV_GU(1) CV_DN(1)
    if (r < I_SQKV) { const int nblk = 6144 / 32, kb = r / nblk, nb = r % nblk, n0 = 32 * nb;
        if (n0 < 5120) { const int seg = (n0 & 127) >> 5; transpose_item(F.in[22], 6144, 64 * kb, n0, (bf16*)(F.ws + WS_WSQKV), D, (n0 & ~127) + 64 * (seg >> 1) + 4 * (seg & 1), scr, F.lane, true); }
        else transpose_item(F.in[22], 6144, 64 * kb, n0, (bf16*)(F.ws + WS_WSQKV), D, n0, scr, F.lane);
        return; } r -= I_SQKV;
    if (r < I_O) { tr_plain(F.in[23], D, D, (bf16*)(F.ws + WS_WSO), r, scr, F.lane); return; } r -= I_O;
    CV_GU(2) CV_DN(2)
    if (r < I_NQKV) { tr_plain(F.in[27], D, 12288, (bf16*)(F.ws + WS_WNQKV), r, scr, F.lane); return; } r -= I_NQKV;
    if (r < I_O) { tr_plain(F.in[28], D, D, (bf16*)(F.ws + WS_WNO), r, scr, F.lane); return; } r -= I_O;
    CV_GU(3) CV_DN(3)
#undef CV_GU
#undef CV_DN
}
__device__ __forceinline__ void conv_window(Frame& F, int widx, int start, int count) {
    LAS float* scr = (LAS float*)(F.lds + RING_OFF + F.wave * 16384);
    volatile LAS unsigned* MISC = (volatile LAS unsigned*)(F.lds + MISC_OFF);
    unsigned* cnt = (unsigned*)(F.ws + WS_CTL) + CW_CONV + 64 * (widx + F.cvo);
    const int nb = (count + 63) >> 6;
    for (;;) {
        __syncthreads();
        if (F.tid == 0) MISC[4] = __hip_atomic_fetch_add(cnt, 1u, __ATOMIC_RELAXED, __HIP_MEMORY_SCOPE_AGENT);
        __syncthreads();
        const int k = (int)MISC[4];
        if (k >= nb) break;
        const int i0 = start + k * 64, i1 = (i0 + 64 < start + count) ? i0 + 64 : start + count;
        for (int i = i0 + F.wave; i < i1; i += NWAVES) conv_item(F, i, scr);
    }
    __syncthreads();
}

__device__ __forceinline__ void p1_adaln2(Frame& F) {
    LAS float* hid = (LAS float*)(F.lds + RING_OFF);
    LAS float* red = (LAS float*)(F.lds + RING_OFF + 8192);
    for (int it = blockIdx.x; it < 4 * 96; it += F.G) {
        const int l = it / 96, jb = it % 96;
        __syncthreads();
        for (int i = F.tid; i < 2 * RANK; i += NWAVES * 64) { const int v = i >> 10, r = i & 1023; float s = 0.f;
#pragma unroll
            for (int ks = 0; ks < 32; ++ks) s += ((const float*)(F.ws + WS_HIDP))[((size_t)(l * 32 + ks) * 2 + v) * RANK + r];
            hid[i] = s; }
        __syncthreads();
        const float* up = F.in[5] + ((size_t)l * RANK + F.wave * 128) * (6 * D) + jb * 256 + F.lane * 4;
        f32x4 a0 = {0.f, 0.f, 0.f, 0.f}, a1 = {0.f, 0.f, 0.f, 0.f};
#pragma unroll 8
        for (int r = 0; r < 128; ++r) { const f32x4 w = __builtin_nontemporal_load((const f32x4*)(up + (size_t)r * (6 * D))); a0 += hid[F.wave * 128 + r] * w; a1 += hid[RANK + F.wave * 128 + r] * w; }
        *(LAS f32x4*)(red + (F.wave * 2 + 0) * 256 + F.lane * 4) = a0;
        *(LAS f32x4*)(red + (F.wave * 2 + 1) * 256 + F.lane * 4) = a1;
        __syncthreads();
        { const int v = F.tid >> 8, c = F.tid & 255; float s = F.in[6][(size_t)l * 6 * D + jb * 256 + c];
#pragma unroll
          for (int w = 0; w < 8; ++w) s += red[(w * 2 + v) * 256 + c];
          ((float*)(F.ws + WS_MOD))[((size_t)(l * 2 + v) * 6) * D + jb * 256 + c] = s; }
    }
}

__device__ __forceinline__ void norm_mod_phase(Frame& F, const float* xl, const float* xc, const float* gain, int l, int ish, int isc, int nrows, const float* slab = nullptr, int nslab = 0) {
    bf16* U = (bf16*)(F.ws + WS_U);
    volatile LAS unsigned* MISC = (volatile LAS unsigned*)(F.lds + MISC_OFF);
    const int b = F.vcu, n_ctx = nrows > SEQ ? (CTXL - b + F.G - 1) / F.G : 0, n_items = n_ctx + (SEQ - b + F.G - 1) / F.G;
    __syncthreads();
    if (F.tid == 0) MISC[5] = 0u;
    __syncthreads();
    for (;;) {
        int idx = 0; if (F.lane == 0) idx = (int)__hip_atomic_fetch_add((LAS unsigned*)(F.lds + MISC_OFF + 20), 1u, __ATOMIC_RELAXED, __HIP_MEMORY_SCOPE_WORKGROUP);
        idx = __builtin_amdgcn_readfirstlane(idx);
        if (idx >= n_items) break;
        const int m = idx < n_ctx ? SEQ + b + idx * F.G : b + (idx - n_ctx) * F.G;
        const bool c = m >= SEQ; const float* xr = c ? xc + (size_t)(m - SEQ) * D : xl + (size_t)m * D;
        const float* sh = modp(F, l, c ? 1 : 0, ish); const float* scl = modp(F, l, c ? 1 : 0, isc);
        f32x4 v[16]; float ss = 0.f;
#pragma unroll
        for (int j = 0; j < 16; ++j) v[j] = __builtin_nontemporal_load((const f32x4*)(xr + j * 256 + F.lane * 4));
        if (c && nslab > 0) {
            for (int sl = 0; sl < nslab; ++sl) { const float* sp = slab + ((size_t)sl * CTXL + (m - SEQ)) * D + F.lane * 4;
#pragma unroll
                for (int j = 0; j < 16; ++j) v[j] += *(const f32x4*)(sp + j * 256); }
#pragma unroll
            for (int j = 0; j < 16; ++j) *(f32x4*)((float*)xr + j * 256 + F.lane * 4) = v[j];
        }
#pragma unroll
        for (int j = 0; j < 16; ++j) { ss += (v[j][0] * v[j][0] + v[j][1] * v[j][1]) + (v[j][2] * v[j][2] + v[j][3] * v[j][3]); }
        const float rstd = rsqrtf(wave_sum(ss) * (1.0f / D) + RMS_EPS);
#pragma unroll
        for (int j = 0; j < 16; ++j) { const int e = j * 256 + F.lane * 4;
            const f32x4 g = *(const f32x4*)(gain + e), s1 = *(const f32x4*)(scl + e), s0 = *(const f32x4*)(sh + e);
            const f32x4 o = v[j] * rstd * g * (1.0f + s1) + s0;
            u32x2 w; w.x = pk2(o[0], o[1]); w.y = pk2(o[2], o[3]);
            *(u32x2*)(U + (size_t)m * D + e) = w; }
    }
}

__device__ __forceinline__ void pool_phase(Frame& F, int nrows) {
    const bf16* U = (const bf16*)(F.ws + WS_U); bf16* P = (bf16*)(F.ws + WS_P);
    const int nranges = nrows / 32;
    for (int it = F.gw; it < nranges * 8; it += F.NGW) {
        const int rg = it >> 3, slab = it & 7, m0 = rg * 32;
        const bool c = m0 >= SEQ; const int t0 = c ? m0 - SEQ : m0, L = c ? CTXL : SEQ, rb = c ? SEQ : 0;
        const int w2 = 1 << (slab >> 1), e = (slab * 64 + F.lane) * 8;
        float a[8];
#pragma unroll
        for (int q = 0; q < 8; ++q) a[q] = 0.f;
#define PL_ADD(row, sgn) do { const u32x4 x = *(const u32x4*)(U + (size_t)(rb + (row)) * D + e); \
            a[0] += (sgn) * bflo(x.x); a[1] += (sgn) * bfhi(x.x); a[2] += (sgn) * bflo(x.y); a[3] += (sgn) * bfhi(x.y); a[4] += (sgn) * bflo(x.z); a[5] += (sgn) * bfhi(x.z); a[6] += (sgn) * bflo(x.w); a[7] += (sgn) * bfhi(x.w); } while (0)
        { const int lo = (t0 - w2 > 0) ? t0 - w2 : 0, hi = (t0 + w2 < L) ? t0 + w2 : L; for (int s = lo; s < hi; ++s) PL_ADD(s, 1.0f); }
        for (int t = t0; t < t0 + 32; ++t) {
            const int lo = (t - w2 > 0) ? t - w2 : 0, hi = (t + w2 < L) ? t + w2 : L;
            const float inv = 1.0f / (float)(hi - lo);
            const u32x4 x = *(const u32x4*)(U + (size_t)(rb + t) * D + e);
            u32x4 o; o.x = pk2(a[0] * inv - bflo(x.x), a[1] * inv - bfhi(x.x)); o.y = pk2(a[2] * inv - bflo(x.y), a[3] * inv - bfhi(x.y));
            o.z = pk2(a[4] * inv - bflo(x.z), a[5] * inv - bfhi(x.z)); o.w = pk2(a[6] * inv - bflo(x.w), a[7] * inv - bfhi(x.w));
            *(u32x4*)(P + (size_t)(rb + t) * D + e) = o;
            if (t + w2 < L) PL_ADD(t + w2, 1.0f);
            if (t - w2 >= 0) PL_ADD(t - w2, -1.0f);
        }
#undef PL_ADD
    }
}

#define MFMA32(a, b, c) __builtin_amdgcn_mfma_f32_32x32x16_bf16((a), (b), (c), 0, 0, 0)
__device__ __forceinline__ int crow(int reg, int h) { return (reg & 3) + 8 * (reg >> 2) + 4 * h; }
__device__ __forceinline__ int chunk_row(int chunk, int j) { return chunk < 16 ? SEQ + chunk * 16 + j : (chunk - 16) * 16 + j; }
__device__ __forceinline__ float gelu_tanh(float x) { const float z = 0.7978845608f * (x + 0.044715f * x * x * x); return x * (1.0f - __frcp_rn(1.0f + __expf(2.0f * z))); }

__device__ __forceinline__ void s5_matgen(Frame& F, int g) {
    LAS float* zt = (LAS float*)(F.lds + RING_OFF);
    LAS float* bbt = zt + 256;
    LAS float* apw = bbt + 4096;
    LAS float* Ct = apw + 4352;
    LAS float* Kt = Ct + 4096;
    const int t = F.tid;
    __syncthreads();
    if (t < 128) {
        const int dir = t >> 6, p = t & 63; const size_t ip = ((size_t)dir * 256 + g) * 64 + p;
        const float lr = F.in[13][ip], li = F.in[14][ip], dt = expf(F.in[15][dir * 256 + g]);
        const float zr = lr * dt, zi = li * dt;
        float sn, cs; sincosf(zi, &sn, &cs);
        const float sh = sinf(0.5f * zi);
        const float em1 = expm1f(zr), mag = em1 + 1.0f;
        const float am1r = em1 * cs - 2.0f * sh * sh, ai = mag * sn;
        const float den = lr * lr + li * li;
        const float kr = (am1r * lr + ai * li) / den, ki = (ai * lr - am1r * li) / den;
        zt[(dir * 64 + p) * 2 + 0] = zr; zt[(dir * 64 + p) * 2 + 1] = zi;
#pragma unroll
        for (int h = 0; h < 16; ++h) { const float br = F.in[16][ip * 16 + h], bi = F.in[17][ip * 16 + h];
            bbt[((dir * 64 + p) * 16 + h) * 2 + 0] = kr * br - ki * bi; bbt[((dir * 64 + p) * 16 + h) * 2 + 1] = kr * bi + ki * br; }
    }
    for (int e = t; e < 2048; e += NWAVES * 64) { const int dir = e >> 10, h = (e >> 6) & 15, p = e & 63; const size_t ic = (((size_t)dir * 256 + g) * 16 + h) * 64 + p;
        Ct[e * 2 + 0] = F.in[18][ic]; Ct[e * 2 + 1] = F.in[19][ic]; }
    __syncthreads();
    for (int e = t; e < 2176; e += NWAVES * 64) { const int dir = e / 1088, rem = e % 1088, d = rem >> 6, p = rem & 63;
        const float zr = zt[(dir * 64 + p) * 2], zi = zt[(dir * 64 + p) * 2 + 1];
        const float mag = expf((float)d * zr); float sn, cs; sincosf((float)d * zi, &sn, &cs);
        apw[e * 2 + 0] = mag * cs; apw[e * 2 + 1] = mag * sn; }
    __syncthreads();
    for (int cbo = 0; cbo < 4; ++cbo) {
        const int dd = F.wave * 4 + cbo, dir = dd >> 4, d = dd & 15, lr16 = F.lane & 15, lq = F.lane >> 4;
        f32x4 kacc = {0.f, 0.f, 0.f, 0.f};
#pragma unroll 4
        for (int p0 = 0; p0 < 64; p0 += 4) { const int p = p0 + lq;
            const float ar = apw[((dir * 17 + d) * 64 + p) * 2], ai = apw[((dir * 17 + d) * 64 + p) * 2 + 1];
            const float br = bbt[((dir * 64 + p) * 16 + lr16) * 2], bi = bbt[((dir * 64 + p) * 16 + lr16) * 2 + 1];
            const float wr = ar * br - ai * bi, wi = ar * bi + ai * br;
            const float cr = Ct[((dir * 16 + lr16) * 64 + p) * 2], ci = Ct[((dir * 16 + lr16) * 64 + p) * 2 + 1];
            kacc = __builtin_amdgcn_mfma_f32_16x16x4f32(cr, wr, kacc, 0, 0, 0);
            kacc = __builtin_amdgcn_mfma_f32_16x16x4f32(-ci, wi, kacc, 0, 0, 0); }
#pragma unroll
        for (int i = 0; i < 4; ++i) Kt[(dir * 16 + d) * 256 + (4 * lq + i) * 16 + lr16] = kacc[i];
    }
    __syncthreads();
    bf16* MF = (bf16*)(F.ws + WS_MF) + (size_t)g * 256 * 512; bf16* EG = (bf16*)(F.ws + WS_EG) + (size_t)g * 256 * 256;
    for (int e = t; e < 256 * 64; e += NWAVES * 64) {
        const int n = e >> 6, k0 = (e & 63) * 8, i = n >> 4, h = n & 15; float v[8];
        if (k0 < 256) { const int j = k0 >> 4, hp0 = k0 & 15;
#pragma unroll
            for (int q = 0; q < 8; ++q) { float x = 0.f; if (j <= i) x += Kt[(0 * 16 + (i - j)) * 256 + h * 16 + hp0 + q]; if (j >= i) x += Kt[(1 * 16 + (j - i)) * 256 + h * 16 + hp0 + q]; v[q] = x; }
        } else { const int q0 = k0 - 256, seg = q0 >> 6, dir = seg >> 1, pw = dir == 0 ? i + 1 : 16 - i;
#pragma unroll
            for (int q = 0; q < 8; ++q) { const int p = (q0 & 63) + q; const float ar = apw[((dir * 17 + pw) * 64 + p) * 2], ai = apw[((dir * 17 + pw) * 64 + p) * 2 + 1];
                const float cr = Ct[((dir * 16 + h) * 64 + p) * 2], ci = Ct[((dir * 16 + h) * 64 + p) * 2 + 1];
                v[q] = (seg & 1) ? -(cr * ai + ci * ar) : (cr * ar - ci * ai); }
        }
        u32x4 o; o.x = pk2(v[0], v[1]); o.y = pk2(v[2], v[3]); o.z = pk2(v[4], v[5]); o.w = pk2(v[6], v[7]);
        *(u32x4*)(MF + ((size_t)(((k0 >> 4) * 8 + (n >> 5)) * 64 + ((k0 >> 3) & 1) * 32 + (n & 31))) * 8) = o;
    }
    for (int e = t; e < 256 * 32; e += NWAVES * 64) {
        const int n = e >> 5, k0 = (e & 31) * 8, seg = n >> 6, p = n & 63, dir = seg >> 1, j = k0 >> 4, hp0 = k0 & 15, pw = dir == 0 ? 15 - j : j; float v[8];
        const float ar = apw[((dir * 17 + pw) * 64 + p) * 2], ai = apw[((dir * 17 + pw) * 64 + p) * 2 + 1];
#pragma unroll
        for (int q = 0; q < 8; ++q) { const float br = bbt[((dir * 64 + p) * 16 + hp0 + q) * 2], bi = bbt[((dir * 64 + p) * 16 + hp0 + q) * 2 + 1];
            v[q] = (seg & 1) ? (ar * bi + ai * br) : (ar * br - ai * bi); }
        u32x4 o; o.x = pk2(v[0], v[1]); o.y = pk2(v[2], v[3]); o.z = pk2(v[4], v[5]); o.w = pk2(v[6], v[7]);
        *(u32x4*)(EG + ((size_t)(((k0 >> 4) * 8 + (n >> 5)) * 64 + ((k0 >> 3) & 1) * 32 + (n & 31))) * 8) = o;
    }
    __syncthreads();
}

#define S5_STAGE(src_expr, w0, nw) do { for (int _q = F.wave - (w0); _q < 128; _q += (nw)) { const int q = _q; \
        __builtin_amdgcn_global_load_lds((const unsigned*)((src_expr) + F.lane * 8), (LAS unsigned*)(F.lds + RING_OFF + q * 1024), 16, 0, 2); } } while (0)
__device__ __forceinline__ void s5_phase(Frame& F) {
    const bf16* U = (const bf16*)(F.ws + WS_U); bf16* Gb = (bf16*)(F.ws + WS_P); const int r = F.lane & 31, h = F.lane >> 5;
    const LAS unsigned char* img = F.lds + RING_OFF;
    for (int g = F.vcu; g < 256; g += F.G) {
        const bf16* EG = (const bf16*)(F.ws + WS_EG) + (size_t)g * 256 * 256;
        const bf16* MF = (const bf16*)(F.ws + WS_MF) + (size_t)g * 256 * 512;
        float* HL = (float*)(F.ws + WS_HLOC) + (size_t)g * 528 * 256;
        bf16* HCg = (bf16*)(F.ws + WS_HC) + (size_t)g * 17 * 16 * 512;
        S5_STAGE(EG + (size_t)q * 512, 0, NWAVES);
        asm volatile("s_waitcnt vmcnt(0)" ::: "memory"); __syncthreads();
        for (int cb = F.wave; cb < 16; cb += NWAVES) {
            const int chunk = cb * 32 + r;
            f32x16 acc[8];
#pragma unroll
            for (int nb = 0; nb < 8; ++nb)
#pragma unroll
                for (int i = 0; i < 16; ++i) acc[nb][i] = 0.f;
#pragma unroll 1
            for (int k0 = 0; k0 < 16; k0 += 4) {
                bf16x8 a[4];
#pragma unroll
                for (int q = 0; q < 4; ++q) a[q] = *(const bf16x8*)(U + (size_t)chunk_row(chunk, k0 + q) * D + g * 16 + 8 * h);
#pragma unroll
                for (int q = 0; q < 4; ++q)
#pragma unroll
                    for (int nh4 = 0; nh4 < 2; ++nh4) { bf16x8 b[4];
                        __builtin_amdgcn_sched_barrier(0);
#pragma unroll
                        for (int nb = 0; nb < 4; ++nb) b[nb] = *(const LAS bf16x8*)(img + (((k0 + q) * 8 + nh4 * 4 + nb) * 64 + F.lane) * 16);
                        __builtin_amdgcn_sched_barrier(0);
#pragma unroll
                        for (int nb = 0; nb < 4; ++nb) acc[nh4 * 4 + nb] = MFMA32(a[q], b[nb], acc[nh4 * 4 + nb]); }
            }
#pragma unroll
            for (int nb = 0; nb < 8; ++nb)
#pragma unroll
                for (int i = 0; i < 16; ++i) HL[(size_t)(cb * 32 + crow(i, h)) * 256 + nb * 32 + r] = acc[nb][i];
        }
        {
            int chunk = 512 + r; if (chunk > 527) chunk = 527;
            f32x16 acc1;
#pragma unroll
            for (int i = 0; i < 16; ++i) acc1[i] = 0.f;
#pragma unroll 1
            for (int k0 = 0; k0 < 16; k0 += 8) { bf16x8 a[8];
#pragma unroll
                for (int q = 0; q < 8; ++q) a[q] = *(const bf16x8*)(U + (size_t)chunk_row(chunk, k0 + q) * D + g * 16 + 8 * h);
#pragma unroll
                for (int q = 0; q < 8; ++q) acc1 = MFMA32(a[q], *(const LAS bf16x8*)(img + (((k0 + q) * 8 + F.wave) * 64 + F.lane) * 16), acc1); }
#pragma unroll
            for (int i = 0; i < 16; ++i) { const int ch = 512 + crow(i, h); if (ch < 528) HL[(size_t)ch * 256 + F.wave * 32 + r] = acc1[i]; }
        }
        asm volatile("s_waitcnt vmcnt(0)" ::: "memory"); __syncthreads();
        S5_STAGE(MF + (size_t)(((q >> 2) * 8 + (q & 3)) * 512), 0, NWAVES);
        {
            const int dir = F.wave & 1, seg = F.wave >> 1, p = F.lane; const size_t ip = ((size_t)dir * 256 + g) * 64 + p;
            const float lr = F.in[13][ip], li = F.in[14][ip], dt = expf(F.in[15][dir * 256 + g]);
            const float mag = expf(16.0f * lr * dt); float sn, cs; sincosf(16.0f * li * dt, &sn, &cs);
            const float ar = mag * cs, ai = mag * sn;
            float qr = ar, qi = ai, a4r = 0.f, a4i = 0.f;
#pragma unroll
            for (int e = 1; e <= 7; ++e) { const float tr = qr * qr - qi * qi, ti = 2.0f * qr * qi; qr = tr; qi = ti; if (e == 2) { a4r = qr; a4i = qi; } }
            const float Ar = qr * a4r - qi * a4i, Ai = qr * a4i + qi * a4r;
            const float* HLp = HL + dir * 128 + p;
            const int nre = dir * 128 + p, nim = nre + 64;
            const int ore = ((nre >> 4) * 64 + ((nre >> 3) & 1) * 32) * 8 + (nre & 7), oim = ((nim >> 4) * 64 + ((nim >> 3) & 1) * 32) * 8 + (nim & 7);
            LAS float* ex = (LAS float*)(F.lds + MISC_OFF + 4096);
            float hr = 0.f, hi = 0.f;
            for (int s0 = 132 * seg; s0 < 132 * seg + 132; s0 += 22) {
                float xr[22], xi[22];
#pragma unroll
                for (int q = 0; q < 22; ++q) { const int s = s0 + q, c = dir == 0 ? s : (s < 16 ? 15 - s : 543 - s); xr[q] = HLp[(size_t)c * 256]; xi[q] = HLp[(size_t)c * 256 + 64]; }
#pragma unroll
                for (int q = 0; q < 22; ++q) { const float nr = ar * hr - ai * hi + xr[q], ni = ar * hi + ai * hr + xi[q]; hr = nr; hi = ni; }
            }
            ex[((dir * 4 + seg) * 64 + p) * 2] = hr; ex[((dir * 4 + seg) * 64 + p) * 2 + 1] = hi;
            asm volatile("s_waitcnt lgkmcnt(0)" ::: "memory"); __builtin_amdgcn_s_barrier(); asm volatile("" ::: "memory");
            hr = 0.f; hi = 0.f;
            for (int q = 0; q < seg; ++q) { const float er = ex[((dir * 4 + q) * 64 + p) * 2], ei = ex[((dir * 4 + q) * 64 + p) * 2 + 1];
                const float nr = Ar * hr - Ai * hi + er, ni = Ar * hi + Ai * hr + ei; hr = nr; hi = ni; }
            for (int s0 = 132 * seg; s0 < 132 * seg + 132; s0 += 22) {
                float xr[22], xi[22];
#pragma unroll
                for (int q = 0; q < 22; ++q) { const int s = s0 + q, c = dir == 0 ? s : (s < 16 ? 15 - s : 543 - s); xr[q] = HLp[(size_t)c * 256]; xi[q] = HLp[(size_t)c * 256 + 64]; }
#pragma unroll
                for (int q = 0; q < 22; ++q) {
                    const int s = s0 + q, c = dir == 0 ? s : (s < 16 ? 15 - s : 543 - s);
                    { const size_t cbo = (size_t)(c >> 5) * 16 * 512 + (c & 31) * 8; HCg[cbo + ore] = (bf16)(pk2(hr, 0.f) & 0xffffu); HCg[cbo + oim] = (bf16)(pk2(hi, 0.f) & 0xffffu); }
                    const float nr = ar * hr - ai * hi + xr[q], ni = ar * hi + ai * hr + xi[q]; hr = nr; hi = ni; }
            }
        }
        asm volatile("s_waitcnt vmcnt(0)" ::: "memory"); __syncthreads();
        for (int nh = 0; nh < 2; ++nh) {
            if (nh == 1) { __syncthreads(); S5_STAGE(MF + (size_t)(((q >> 2) * 8 + 4 + (q & 3)) * 512), 0, NWAVES); asm volatile("s_waitcnt vmcnt(0)" ::: "memory"); __syncthreads(); }
            const int hh = r & 15; const float dv = F.in[20][g * 16 + hh];
            for (int cb = F.wave; cb < 16; cb += NWAVES) {
                const int chunk = cb * 32 + r;
                const bf16* HC = HCg + (size_t)cb * 16 * 512 + F.lane * 8;
                f32x16 acc[4];
#pragma unroll
                for (int nb = 0; nb < 4; ++nb)
#pragma unroll
                    for (int i = 0; i < 16; ++i) acc[nb][i] = 0.f;
#pragma unroll
                for (int part = 0; part < 2; ++part) {
                    bf16x8 a[16];
#pragma unroll
                    for (int q = 0; q < 16; ++q) a[q] = part == 0 ? *(const bf16x8*)(U + (size_t)chunk_row(chunk, q) * D + g * 16 + 8 * h) : *(const bf16x8*)(HC + (size_t)q * 512);
#pragma unroll
                    for (int q = 0; q < 16; ++q) { bf16x8 b[4];
                        __builtin_amdgcn_sched_barrier(0);
#pragma unroll
                        for (int nb = 0; nb < 4; ++nb) b[nb] = *(const LAS bf16x8*)(img + (((part * 16 + q) * 4 + nb) * 64 + F.lane) * 16);
                        __builtin_amdgcn_sched_barrier(0);
#pragma unroll
                        for (int nb = 0; nb < 4; ++nb) acc[nb] = MFMA32(a[q], b[nb], acc[nb]); }
                }
#pragma unroll
                for (int nb = 0; nb < 4; ++nb)
#pragma unroll
                    for (int i = 0; i < 16; ++i) { const int ch = cb * 32 + crow(i, h); const int tok = (nh * 4 + nb) * 2 + (r >> 4); const size_t o = (size_t)chunk_row(ch, tok) * D + g * 16 + hh;
                        const float u = bf2f(U[o]); Gb[o] = (bf16)(pk2(gelu_tanh(acc[nb][i] + dv * u), 0.f) & 0xffffu); }
            }
            if ((F.wave >> 2) == nh) {
                const int nb = F.wave & 3; int chunk = 512 + r; if (chunk > 527) chunk = 527;
                const bf16* HC = HCg + (size_t)16 * 16 * 512 + F.lane * 8;
                f32x16 acc1;
#pragma unroll
                for (int i = 0; i < 16; ++i) acc1[i] = 0.f;
#pragma unroll 1
                for (int k0 = 0; k0 < 32; k0 += 8) { bf16x8 a[8];
#pragma unroll
                    for (int q = 0; q < 8; ++q) a[q] = k0 < 16 ? *(const bf16x8*)(U + (size_t)chunk_row(chunk, k0 + q) * D + g * 16 + 8 * h) : *(const bf16x8*)(HC + (size_t)(k0 - 16 + q) * 512);
#pragma unroll
                    for (int q = 0; q < 8; ++q) acc1 = MFMA32(a[q], *(const LAS bf16x8*)(img + (((k0 + q) * 4 + nb) * 64 + F.lane) * 16), acc1); }
#pragma unroll
                for (int i = 0; i < 16; ++i) { const int ch = 512 + crow(i, h);
                    if (ch < 528) { const int tok = (nh * 4 + nb) * 2 + (r >> 4); const size_t o = (size_t)chunk_row(ch, tok) * D + g * 16 + hh;
                        const float u = bf2f(U[o]); Gb[o] = (bf16)(pk2(gelu_tanh(acc1[i] + dv * u), 0.f) & 0xffffu); } }
            }
        }
        asm volatile("s_waitcnt vmcnt(0)" ::: "memory"); __syncthreads();
    }
}
#undef S5_STAGE


template <bool ROPE>
__device__ __forceinline__ void headnorm_phase(Frame& F, bf16* QK, long ld, int nq, int nk, const float* qg, const float* kg, int nrows) {
    const int i = F.lane & 31, hb = F.lane >> 5;
    const float inv = exp2f(-(float)i * (13.287712379549449f / 32.0f));
    float gq[4], gk[4];
#pragma unroll
    for (int s = 0; s < 4; ++s) { gq[s] = qg[32 * s + i] * QSCALE; gk[s] = kg[32 * s + i]; }
    for (int m = F.gw; m < nrows; m += F.NGW) {
        float cr = 1.f, sr = 0.f, cc = 1.f, sc = 0.f;
        if (ROPE && m < SEQ) { sincosf((float)(m >> 6) * inv, &sr, &cr); sincosf((float)(m & 63) * inv, &sc, &cc); }
        bf16* rowp = QK + (size_t)m * ld;
        for (int hp = 0; hp < nq + nk; hp += 2) {
            const int head = hp + hb; bf16* p = rowp + head * 128 + i;
            const float x0 = bf2f(p[0]), x1 = bf2f(p[32]), x2 = bf2f(p[64]), x3 = bf2f(p[96]);
            float ss = (x0 * x0 + x1 * x1) + (x2 * x2 + x3 * x3);
#pragma unroll
            for (int o = 1; o < 32; o <<= 1) ss += __shfl_xor(ss, o);
            const float rs = rsqrtf(ss * (1.0f / 128.0f) + RMS_EPS);
            const bool isq = head < nq;
            const float y0 = x0 * rs * (isq ? gq[0] : gk[0]), y1 = x1 * rs * (isq ? gq[1] : gk[1]), y2 = x2 * rs * (isq ? gq[2] : gk[2]), y3 = x3 * rs * (isq ? gq[3] : gk[3]);
            const float o0 = y0 * cr - y1 * sr, o1 = y1 * cr + y0 * sr, o2 = y2 * cc - y3 * sc, o3 = y3 * cc + y2 * sc;
            p[0] = (bf16)(pk2(o0, 0.f) & 0xffffu); p[32] = (bf16)(pk2(o1, 0.f) & 0xffffu); p[64] = (bf16)(pk2(o2, 0.f) & 0xffffu); p[96] = (bf16)(pk2(o3, 0.f) & 0xffffu);
        }
    }
}

#define ATT_SOFTMAX(sv, pv, sidx) do { \
        if (MODE == 1 && usebias) { _Pragma("unroll") for (int i = 0; i < 16; ++i) pv[i] = __builtin_amdgcn_exp2f(sv[i] + tabp[32 * (sidx) + 16 * (i >> 3) + (i & 7)]); } \
        else { _Pragma("unroll") for (int i = 0; i < 16; ++i) pv[i] = __builtin_amdgcn_exp2f(sv[i]); } \
        if (mk[sidx]) { _Pragma("unroll") for (int i = 0; i < 16; ++i) { const int ci = 16 * (i >> 3) + (i & 7); \
            const bool valid = (MODE == 1) ? (((vbits >> (16 * (sidx) + i)) & 1u) != 0u) : (ci >= L[sidx] && ci <= H[sidx]); pv[i] = valid ? pv[i] : 0.f; } } \
        _Pragma("unroll") for (int i = 0; i < 16; ++i) lsum += pv[i]; } while (0)
#define ATT_PACK(pv, xsv) do { _Pragma("unroll") for (int st = 0; st < 2; ++st) { u32x4 xw; xw.x = pk2(pv[8 * st], pv[8 * st + 1]); xw.y = pk2(pv[8 * st + 2], pv[8 * st + 3]); \
        xw.z = pk2(pv[8 * st + 4], pv[8 * st + 5]); xw.w = pk2(pv[8 * st + 6], pv[8 * st + 7]); xsv[st] = __builtin_bit_cast(bf16x8, xw); } } while (0)
template <int MODE>
__device__ __forceinline__ void attn_tile2(const LAS unsigned char* Kt, const LAS unsigned char* Vt, const bf16x8 (&qf)[8], f32x16 (&o)[4], float& lsum, float M2, int r, int h, int pr,
                                           const bool (&mk)[2], const int (&L)[2], const int (&H)[2], unsigned vbits, bool usebias, const LAS float* tabp) {
    f32x16 s0, s1;
#pragma unroll
    for (int i = 0; i < 16; ++i) { s0[i] = -M2; s1[i] = -M2; }
    const int rowk0 = pr, rowk1 = 32 + pr, kx = pr & 15;
    bf16x8 fr[8];
    __builtin_amdgcn_sched_barrier(0);
#pragma unroll
    for (int ks = 0; ks < 8; ++ks) fr[ks] = *(const LAS bf16x8*)(Kt + rowk0 * 256 + (((2 * ks + h) ^ kx) << 4));
    __builtin_amdgcn_sched_barrier(0);
#pragma unroll
    for (int ks = 0; ks < 8; ++ks) s0 = MFMA32(fr[ks], qf[ks], s0);
    __builtin_amdgcn_sched_barrier(0);
#pragma unroll
    for (int ks = 0; ks < 8; ++ks) fr[ks] = *(const LAS bf16x8*)(Kt + rowk1 * 256 + (((2 * ks + h) ^ kx) << 4));
    __builtin_amdgcn_sched_barrier(0);
    float p0[16], p1[16]; bf16x8 xs0[2], xs1[2];
#pragma unroll
    for (int ks = 0; ks < 8; ++ks) s1 = MFMA32(fr[ks], qf[ks], s1);
    ATT_SOFTMAX(s0, p0, 0);
    ATT_PACK(p0, xs0);
    __builtin_amdgcn_sched_barrier(0);
#pragma unroll
    for (int st = 0; st < 2; ++st)
#pragma unroll
        for (int db = 0; db < 4; ++db) { const int rowv = db * 32 + r, vx = (rowv >> 1) & 7; fr[st * 4 + db] = *(const LAS bf16x8*)(Vt + rowv * 128 + (((2 * st + h) ^ vx) << 4)); }
    __builtin_amdgcn_sched_barrier(0);
#pragma unroll
    for (int st = 0; st < 2; ++st)
#pragma unroll
        for (int db = 0; db < 4; ++db) o[db] = MFMA32(fr[st * 4 + db], xs0[st], o[db]);
    ATT_SOFTMAX(s1, p1, 1);
    ATT_PACK(p1, xs1);
    __builtin_amdgcn_sched_barrier(0);
#pragma unroll
    for (int st = 0; st < 2; ++st)
#pragma unroll
        for (int db = 0; db < 4; ++db) { const int rowv = db * 32 + r, vx = (rowv >> 1) & 7; fr[st * 4 + db] = *(const LAS bf16x8*)(Vt + rowv * 128 + (((4 + 2 * st + h) ^ vx) << 4)); }
    __builtin_amdgcn_sched_barrier(0);
#pragma unroll
    for (int st = 0; st < 2; ++st)
#pragma unroll
        for (int db = 0; db < 4; ++db) o[db] = MFMA32(fr[st * 4 + db], xs1[st], o[db]);
    __builtin_amdgcn_sched_barrier(0);
}
#undef ATT_SOFTMAX
#undef ATT_PACK

template <int MODE>
__device__ __forceinline__ void attn_phase(Frame& F, const bf16* QK, long ldqk, int koff, const bf16* VT, long ldv, const float* qg, const float* kg, const float* extra, bool ctx_out) {
    bf16* O = (bf16*)(F.ws + WS_P); const int r = F.lane & 31, h = F.lane >> 5, pr = (r & ~12) | ((r & 4) << 1) | ((r & 8) >> 1);
    LAS unsigned char* KB = F.lds + RING_OFF;
    LAS float* tab = (LAS float*)(F.lds + MISC_OFF + 256);
    float mq = fmaxf(fabsf(qg[F.lane]), fabsf(qg[64 + F.lane])), mk = fmaxf(fabsf(kg[F.lane]), fabsf(kg[64 + F.lane]));
#pragma unroll
    for (int o = 1; o < 64; o <<= 1) { mq = fmaxf(mq, __shfl_xor(mq, o)); mk = fmaxf(mk, __shfl_xor(mk, o)); }
    const float M2 = 11.313708498984761f * mq * mk * LOG2E;
    const int n_lat = 1024, n_items = n_lat + (ctx_out ? (MODE == 0 ? 32 : 128) : 0);
    const int w = F.wave;
    for (int it = F.vcu; it < n_items; it += F.G) {
        int hq, hkv, q0, lbase = 0, nl = 0, rw = 0, qh = 0, r0w = 0, krlo = 0;
        if (it < n_lat) {
            if (MODE == 0) { hkv = it >> 7; const int qb = it & 127; hq = hkv * 4 + (w & 3); q0 = qb * 64 + 32 * (w >> 2);
                lbase = qb * 64 - 128; if (lbase < 0) lbase = 0; int lend = qb * 64 + 192; if (lend > SEQ) lend = SEQ; nl = (lend - lbase) >> 6; }
            else { hkv = hq = it >> 5; const int R0 = 4 * (it & 31); rw = R0 + (w >> 1); qh = w & 1; q0 = rw * 64 + 32 * qh;
                r0w = rw - 4; r0w = r0w < 0 ? 0 : (r0w > 120 ? 120 : r0w);
                krlo = R0 - 4; krlo = krlo < 0 ? 0 : (krlo > 120 ? 120 : krlo); int khi = R0 - 1; khi = khi < 0 ? 0 : (khi > 120 ? 120 : khi); khi += 7;
                lbase = krlo * 64; nl = khi - krlo + 1; }
        } else {
            const int j = it - n_lat;
            if (MODE == 0) { hkv = j >> 2; hq = hkv * 4 + (w & 3); q0 = SEQ + (j & 3) * 64 + 32 * (w >> 2); }
            else { hkv = hq = j >> 2; q0 = SEQ + (j & 3) * 64 + 32 * (w & 1); }
        }
        const int nt = nl + 4;
        const int cq = qh * 32 + r; int c0 = cq - 8; c0 = c0 < 0 ? 0 : (c0 > 48 ? 48 : c0);
        unsigned vbits = 0u;
        if (MODE == 1) {
#pragma unroll
            for (int e = 0; e < 32; ++e) { const int kc = 32 * (e >> 4) + 16 * ((e & 15) >> 3) + 8 * h + (e & 7); if (kc >= c0 && kc < c0 + 16) vbits |= 1u << e; } }
        float Mi = M2;
        if (MODE == 1) {
            float bm = 0.f;
            if (w == 0) { for (int e = F.lane; e < 465; e += 64) tab[e] = extra[hq * 465 + e] * LOG2E; LDS_WAIT(); }
            for (int e = F.lane; e < 465; e += 64) bm = fmaxf(bm, fabsf(extra[hq * 465 + e]));
#pragma unroll
            for (int o = 1; o < 64; o <<= 1) bm = fmaxf(bm, __shfl_xor(bm, o));
            Mi += bm * LOG2E;
        }
        bf16x8 qf[8];
#pragma unroll
        for (int ks = 0; ks < 8; ++ks) qf[ks] = *(const bf16x8*)(QK + (size_t)(q0 + r) * ldqk + hq * 128 + 16 * ks + 8 * h);
        f32x16 o[4];
#pragma unroll
        for (int db = 0; db < 4; ++db)
#pragma unroll
            for (int i = 0; i < 16; ++i) o[db][i] = 0.f;
        float lsum = 0.f;
        const bf16* kbase = QK + koff + hkv * 128; const bf16* vbase = VT + (size_t)hkv * 128 * ldv;
#define ATT_KEY0(j) ((j) < nl ? lbase + 64 * (j) : SEQ + 64 * ((j) - nl))
#define ATT_GLDS(j, b) do { const int _k0 = ATT_KEY0(j); _Pragma("unroll") for (int _i = 0; _i < 2; ++_i) { const int _q = w + 8 * _i; \
            { const int _row = _q * 4 + (F.lane >> 4), _ch = (F.lane & 15) ^ (_row & 15); \
              __builtin_amdgcn_global_load_lds((const unsigned*)(kbase + (size_t)(_k0 + _row) * ldqk + _ch * 8), (LAS unsigned*)(KB + (b) * 32768 + _q * 1024), 16, 0, 0); } \
            { const int _row = _q * 8 + (F.lane >> 3), _ch = (F.lane & 7) ^ ((_row >> 1) & 7); \
              __builtin_amdgcn_global_load_lds((const unsigned*)(vbase + (size_t)_row * ldv + _k0 + _ch * 8), (LAS unsigned*)(KB + (b) * 32768 + 16384 + _q * 1024), 16, 0, 0); } } } while (0)
        ATT_GLDS(0, 0); if (nt > 1) ATT_GLDS(1, 1);
        asm volatile("" : "+v"(qf[0]), "+v"(qf[1]), "+v"(qf[2]), "+v"(qf[3]), "+v"(qf[4]), "+v"(qf[5]), "+v"(qf[6]), "+v"(qf[7]));
        int bcur = 0;
        for (int j = 0; j < nt; ++j) {
            if (j + 1 < nt) asm volatile("s_waitcnt vmcnt(4)" ::: "memory"); else asm volatile("s_waitcnt vmcnt(0)" ::: "memory");
            asm volatile("s_waitcnt lgkmcnt(0)" ::: "memory"); __builtin_amdgcn_s_barrier(); asm volatile("" ::: "memory");
            if (j + 2 < nt) { const int b2 = bcur >= 1 ? bcur - 1 : 2; ATT_GLDS(j + 2, b2); }
            const LAS unsigned char* Kt = KB + bcur * 32768; const LAS unsigned char* Vt = Kt + 16384;
            {
                bool rel = true, ub = false; bool mk[2] = {false, false}; int L[2] = {0, 0}, H[2] = {0, 0}; const LAS float* tabp = tab;
                if (j < nl) {
                    if (MODE == 0) { bool any = false;
#pragma unroll
                        for (int sub = 0; sub < 2; ++sub) { const int dd = lbase + 64 * j + 32 * sub - (q0 - 128); const bool rl = dd >= 0 && dd <= 256; any = any || rl;
                            mk[sub] = (dd == 0) || (dd == 256) || !rl; L[sub] = !rl ? 1000 : ((dd == 0) ? r - 8 * h : -1000); H[sub] = !rl ? -1000 : ((dd == 256) ? r - 8 * h : 1000); }
                        rel = any; }
                    else { const int kr = krlo + j; rel = kr >= r0w && kr <= r0w + 7; mk[0] = mk[1] = true; ub = true; tabp = tab + ((kr - rw + 7) * 31 + 8 * h - cq + 15); }
                }
                if (rel) attn_tile2<MODE>(Kt, Vt, qf, o, lsum, Mi, r, h, pr, mk, L, H, vbits, ub, tabp);
            }
            bcur = bcur == 2 ? 0 : bcur + 1;
        }
#undef ATT_KEY0
#undef ATT_GLDS
        float l = lsum + __shfl_xor(lsum, 32);
        if (MODE == 0) l += __builtin_amdgcn_exp2f(extra[hq] * LOG2E - Mi);
        const float il = 1.0f / l;
        bf16* orow = O + (size_t)(q0 + r) * D + hq * 128;
#pragma unroll
        for (int db = 0; db < 4; ++db)
#pragma unroll
            for (int gq4 = 0; gq4 < 4; ++gq4) { u32x2 wv; wv.x = pk2(o[db][4 * gq4] * il, o[db][4 * gq4 + 1] * il); wv.y = pk2(o[db][4 * gq4 + 2] * il, o[db][4 * gq4 + 3] * il);
                *(u32x2*)(orow + db * 32 + 8 * gq4 + 4 * h) = wv; }
        asm volatile("s_waitcnt vmcnt(0) lgkmcnt(0)" ::: "memory"); __builtin_amdgcn_s_barrier(); asm volatile("" ::: "memory");
    }
}

__global__ void __launch_bounds__(NWAVES * 64, 2) mk_fwd(Args args) {
    extern __shared__ __attribute__((aligned(16))) unsigned char lds[];
    Frame F;
    F.lds = (LAS unsigned char*)lds;
    F.tid = threadIdx.x; F.lane = F.tid & 63; F.wave = __builtin_amdgcn_readfirstlane(F.tid >> 6);
    F.G = gridDim.x; { const int bx = blockIdx.x; F.vcu = (F.G % 8 == 0) ? (bx % 8) * (F.G / 8) + bx / 8 : bx; }
    F.gw = F.vcu * NWAVES + F.wave; F.NGW = F.G * NWAVES;
#pragma unroll
    for (int i = 0; i < 32; ++i) F.in[i] = args.in[i];
    F.out = args.out; F.ws = args.ws; F.cvo = args.cvo;
    volatile LAS unsigned* MISC = (volatile LAS unsigned*)(F.lds + MISC_OFF);
    if (F.tid < 16) MISC[F.tid] = 0u;
    __syncthreads();
    unsigned* barw = (unsigned*)(F.ws + WS_CTL) + CW_BAR + args.li * XCD_BAR_WORDS;
    XcdBarrier bar; bar.bar = barw; bar.x = 0; bar.st = nullptr;
    if (!MK_PER_PHASE) bar = xcd_barrier_post(barw, MISC + 8);
#define GRID_BAR() do { if (!MK_PER_PHASE) xcd_barrier(bar); } while (0)
    const int lo = args.ph_lo, hi = args.ph_hi;
#define IN(k) (lo <= (k) && (k) < hi)
#define BOTH(k) (IN(k) && IN((k) + 1))
    LAS unsigned char* ring = F.lds + RING_OFF;
    float* X = (float*)(F.ws + WS_X);
    bf16* U = (bf16*)(F.ws + WS_U); bf16* P = (bf16*)(F.ws + WS_P); bf16* H = (bf16*)(F.ws + WS_H);

    if (IN(0)) { p0_prologue(F); for (int g = blockIdx.x; g < 256; g += F.G) s5_matgen(F, g); conv_window(F, 0, 0, CV_P0); if (BOTH(0)) GRID_BAR(); }
    if (IN(1)) { p1_adaln2(F); if (BOTH(1)) GRID_BAR(); }
    float* XC = X + (size_t)SEQ * D; float* SLAB = (float*)(F.ws + WS_SLAB);

#define FFN_PHASES(pb, l, nM_, nrows_, outl_, CVA, CVB, NS, BG)                                                                                      \
    if (IN(pb)) { norm_mod_phase(F, X, XC, F.in[8] + (l) * D, (l), 3, 4, (nrows_), SLAB, (NS)); if (BOTH(pb)) GRID_BAR(); }             \
    if (IN((pb) + 1)) {                                                                                                              \
        pg8::Gemm gm{U, D, (const bf16*)(F.ws + WS_WGU) + (size_t)(l) * 2 * DFF * D, D, (nM_), 2 * DFF / 256, D, 0, nullptr, nullptr};                  \
        const int GC = F.G - (BG);             \
        pg8::StaticOrder S; S.init((nM_), 2 * DFF / 256, GC, (int)blockIdx.x);                                                       \
        pg8::EpiSwiGLU E{H, DFF};                                                                                                    \
        if ((int)blockIdx.x < GC) pg8::gemm_phase<pg8::EpiSwiGLU>(ring, gm, S, E);                                                   \
        CVA;                                                                                                                         \
        if (BOTH((pb) + 1)) GRID_BAR();                                                                                              \
    }                                                                                                                                \
    if (IN((pb) + 2)) {                                                                                                              \
        pg8::EpiResid E{X, XC, (outl_), XC, modp(F, (l), 0, 5), modp(F, (l), 1, 5), nullptr, 0};                                \
        if ((nM_) == 33) (void)resid_gemm_ctxsplit(ring, F.G, H, DFF, (const bf16*)(F.ws + WS_WDN) + (size_t)(l) * D * DFF, DFF, DFF, E, SLAB);   \
        else { pg8::Gemm gm{H, DFF, (const bf16*)(F.ws + WS_WDN) + (size_t)(l) * D * DFF, DFF, (nM_), D / 256, DFF, 0, nullptr, nullptr};                    \
            pg8::StaticOrder S; S.init((nM_), D / 256, F.G, (int)blockIdx.x); pg8::gemm_phase<pg8::EpiResid>(ring, gm, S, E); }           \
        CVB;                                                                                                                         \
        if (BOTH((pb) + 2)) GRID_BAR();                                                                                              \
    }

    if (IN(2)) { norm_mod_phase(F, F.in[0], F.in[2], F.in[7] + 0 * D, 0, 0, 1, MT); if (BOTH(2)) GRID_BAR(); }
    if (IN(3)) { pool_phase(F, MT); if (BOTH(3)) GRID_BAR(); }
    if (IN(4)) {
        pg8::Gemm gm{P, D, (const bf16*)(F.ws + WS_WPOOL), 1024, 33, 16, 1024, 2048, nullptr, nullptr};
        pg8::StaticOrder S; S.init(33, 16, F.G, (int)blockIdx.x);
        pg8::EpiResid E{F.in[0], F.in[2], X, XC, modp(F, 0, 0, 2), modp(F, 0, 1, 2), F.in[12], 0};
        pg8::gemm_phase<pg8::EpiResid>(ring, gm, S, E);
        conv_window(F, 10, CV_P0, CV_P4 - CV_P0);
        if (BOTH(4)) GRID_BAR();
    }
    FFN_PHASES(5, 0, 33, MT, X, conv_window(F, 1, CV_P4, CV_P6 - CV_P4), (void)0, 0, BG_CONV)

    if (IN(8)) { norm_mod_phase(F, X, XC, F.in[7] + 1 * D, 1, 0, 1, MT, SLAB, slab_count(DFF)); if (BOTH(8)) GRID_BAR(); }
    if (IN(9)) { s5_phase(F); if (BOTH(9)) GRID_BAR(); }
    if (IN(12)) {
        pg8::Gemm gm{P, D, (const bf16*)(F.ws + WS_WGLU), D, 33, 2 * D / 256, D, 0, nullptr, nullptr};
        pg8::StaticOrder S; S.init(33, 2 * D / 256, F.G, (int)blockIdx.x);
        pg8::EpiGLU E{X, XC, X, XC, modp(F, 1, 0, 2), modp(F, 1, 1, 2)};
        pg8::gemm_phase<pg8::EpiGLU>(ring, gm, S, E);
        conv_window(F, 2, CV_P6, CV_P12 - CV_P6);
        if (BOTH(12)) GRID_BAR();
    }
    FFN_PHASES(13, 1, 33, MT, X, conv_window(F, 3, CV_P12, CV_P14 - CV_P12), (void)0, 0, BG_CONV)

    bf16* QK = (bf16*)(F.ws + WS_QK); bf16* VT = (bf16*)(F.ws + WS_VT);
    if (IN(16)) { norm_mod_phase(F, X, XC, F.in[7] + 2 * D, 2, 0, 1, MT, SLAB, slab_count(DFF)); if (BOTH(16)) GRID_BAR(); }
    if (IN(17)) {
        {
          pg8::Gemm gm{U, D, (const bf16*)(F.ws + WS_WSQKV), D, 33, 20, D, 0, (const bf16*)(F.ws + WS_WSQKV) + (size_t)5120 * D, U};
          pg8::StaticOrder S; S.init(33, 20, F.G, (int)blockIdx.x); S.init2(4, 33);
          pg8::EpiHeadNorm<true> E{QK, 5120, F.in[24], F.in[25], 16, (const float*)(F.ws + WS_ROPE), (LAS float*)(F.lds + MISC_OFF + 4096), QSCALE, VT, MT};
          pg8::gemm_phase<pg8::EpiHeadNorm<true>>(ring, gm, S, E); }
        conv_window(F, 4, CV_P14, CV_P17 - CV_P14);
        if (BOTH(17)) GRID_BAR();
    }
    if (IN(19)) { attn_phase<0>(F, QK, 5120, 4096, VT, MT, F.in[24], F.in[25], F.in[26], true); if (BOTH(19)) GRID_BAR(); }
    if (IN(20)) {
        pg8::EpiResid E{X, XC, X, XC, modp(F, 2, 0, 2), modp(F, 2, 1, 2), nullptr, 0};
        (void)resid_gemm_ctxsplit(ring, F.G, P, D, (const bf16*)(F.ws + WS_WSO), D, D, E, SLAB);
        if (BOTH(20)) GRID_BAR();
    }
    FFN_PHASES(21, 2, 33, MT, X, conv_window(F, 6, CV_P17, CV_P22 - CV_P17), (void)0, slab_count(D), BG_CONV)

    if (IN(24)) { norm_mod_phase(F, X, XC, F.in[7] + 3 * D, 3, 0, 1, MT, SLAB, slab_count(DFF)); if (BOTH(24)) GRID_BAR(); }
    if (IN(25)) {
        {
          pg8::Gemm gm{U, D, (const bf16*)(F.ws + WS_WNQKV), D, 33, 32, D, 0, (const bf16*)(F.ws + WS_WNQKV) + (size_t)8192 * D, U};
          pg8::StaticOrder S; S.init(33, 32, F.G, (int)blockIdx.x); S.init2(16, 33);
          pg8::EpiHeadNorm<false> E{QK, 8192, F.in[29], F.in[30], 16, (const float*)(F.ws + WS_ROPE), (LAS float*)(F.lds + MISC_OFF + 4096), QSCALE, VT, MT};
          pg8::gemm_phase<pg8::EpiHeadNorm<false>>(ring, gm, S, E); }
        conv_window(F, 8, CV_P22, CV_P25 - CV_P22);
        if (BOTH(25)) GRID_BAR();
    }
    if (IN(27)) { attn_phase<1>(F, QK, 8192, 4096, VT, MT, F.in[29], F.in[30], F.in[31], false); if (BOTH(27)) GRID_BAR(); }
    if (IN(28)) {
        pg8::Gemm gm{P, D, (const bf16*)(F.ws + WS_WNO), D, 32, D / 256, D, 0, nullptr, nullptr};
        pg8::StaticOrder S; S.init(32, D / 256, F.G, (int)blockIdx.x);
        pg8::EpiResid E{X, XC, X, XC, modp(F, 3, 0, 2), modp(F, 3, 1, 2), nullptr, 0};
        pg8::gemm_phase<pg8::EpiResid>(ring, gm, S, E);
        if (BOTH(28)) GRID_BAR();
    }
    FFN_PHASES(29, 3, 32, SEQ, F.out, (void)0, (void)0, 0, 0)
#undef IN
#undef BOTH
}

constexpr int N_PHASES = 32;
extern "C" void kernel_launch(void* const* d_in, const int* in_sizes, int n_in, void* d_out, int out_size, void* d_ws, size_t ws_size, hipStream_t stream) {
    static int grid = 0;
    if (grid == 0) {
        if (n_in != 32 || ws_size < WS_END) { fprintf(stderr, "kernel_launch: unexpected n_in %d / ws %zu\n", n_in, ws_size); grid = -1; return; }
        int dev = 0, cus = 0, per_cu = 0;
        if (hipGetDevice(&dev) != hipSuccess || hipDeviceGetAttribute(&cus, hipDeviceAttributeMultiprocessorCount, dev) != hipSuccess) { grid = -1; return; }
        if (hipFuncSetAttribute((const void*)mk_fwd, hipFuncAttributeMaxDynamicSharedMemorySize, LDS_BYTES) != hipSuccess) { fprintf(stderr, "kernel_launch: hipFuncSetAttribute failed\n"); grid = -1; return; }
        if (hipOccupancyMaxActiveBlocksPerMultiprocessor(&per_cu, (const void*)mk_fwd, NWAVES * 64, LDS_BYTES) != hipSuccess || per_cu < 1)
            fprintf(stderr, "kernel_launch: occupancy query reports %d\n", per_cu);
        (void)hipGetLastError();
        grid = cus;
    }
    if (grid < 0) return;
    if (hipMemsetAsync((char*)d_ws + WS_CTL, 0, CTL_ZERO_BYTES, stream) != hipSuccess) return;
    Args a{};
    for (int i = 0; i < 32; ++i) a.in[i] = (const float*)d_in[i];
    a.out = (float*)d_out; a.ws = (unsigned char*)d_ws;
    int li = 0;
#define LAUNCH(lo_, hi_) do { a.ph_lo = (lo_); a.ph_hi = (hi_); a.cvo = 16 * li; a.li = li++; hipLaunchKernelGGL(mk_fwd, dim3(grid), dim3(NWAVES * 64), LDS_BYTES, stream, a); } while (0)
    LAUNCH(0, N_PHASES);
#if PROF_SET == 1
    LAUNCH(0, 1); LAUNCH(1, 2);
#elif PROF_SET == 2
    { const int ph[] = {2, 5, 8, 13, 16, 21, 24, 29, 3}; for (int p : ph) LAUNCH(p, p + 1); }
#elif PROF_SET == 3
    { const int ph[] = {6, 14, 22, 30}; for (int p : ph) LAUNCH(p, p + 1); }
#elif PROF_SET == 4
    { const int ph[] = {31, 7, 15, 23}; for (int p : ph) LAUNCH(p, p + 1); }
#elif PROF_SET == 5
    { const int ph[] = {4, 12, 17, 20, 25, 28}; for (int p : ph) LAUNCH(p, p + 1); }
#elif PROF_SET == 10
    LAUNCH(7, 8);
#elif PROF_SET == 11
    LAUNCH(6, 7);
#elif PROF_SET == 12
    LAUNCH(0, 2);
#elif PROF_SET == 7
    { const int ph[] = {9, 10, 11}; for (int p : ph) LAUNCH(p, p + 1); }
#elif PROF_SET == 8
    { const int ph[] = {19, 27}; for (int p : ph) LAUNCH(p, p + 1); }
#elif PROF_SET == 9
    { const int ph[] = {9}; for (int p : ph) LAUNCH(p, p + 1); }
#elif PROF_SET == 6
    { const int ph[] = {9, 10, 11, 19, 27, 18, 26}; for (int p : ph) LAUNCH(p, p + 1); }
#endif
}
```
